# Optimizing an MI355X kernel written in HIP

```python
import math
import jax, jax.numpy as jnp
from jax import lax
import numpy as np

D_MODEL = 2048
BATCH = 2
SEQ = 16384
DEPTH = 2

CHUNK = 64
QBLK = 128
PLE_DIM = 256
ATT_HEADS = 8
ATT_DK = 64
ATT_DV = 2 * ATT_DK
ATT_WIDTH = ATT_HEADS * ATT_DV
SSM_WIDTH = 1024
SSM_GROUP = 16
SSM_GROUPS = SSM_WIDTH // SSM_GROUP
SSM_STATE = 64
SPLIT_SIZES = (
    ATT_HEADS * 2 * ATT_DK,
    ATT_HEADS * 2 * ATT_DK,
    ATT_WIDTH,
    ATT_WIDTH,
    SSM_WIDTH,
    SSM_WIDTH,
    D_MODEL,
    D_MODEL,
    D_MODEL,
)
IN_COLS = sum(SPLIT_SIZES)
SPLIT_POINTS = tuple(int(v) for v in np.cumsum(SPLIT_SIZES)[:-1])
ALPHA = (2.0 * DEPTH) ** 0.25
BETA = (8.0 * DEPTH) ** -0.25
LN_EPS = 1e-5
RMS_EPS = 1e-5
NEG_INF = -1e30

kernel_name = "hybrid_diffattn_s5_deepnorm_trunk"


def layer_norm(x, g, b):
    xf = x.astype(jnp.float32)
    mu = jnp.mean(xf, axis=-1, keepdims=True)
    xc = xf - mu
    var = jnp.mean(xc * xc, axis=-1, keepdims=True)
    y = xc * lax.rsqrt(var + LN_EPS) * g.astype(jnp.float32) + b.astype(jnp.float32)
    return y.astype(x.dtype)


def diff_attention(q, k, v, lam, subln_w, lambda_init):
    B, S = q.shape[0], q.shape[1]
    nblk = S // QBLK
    q1 = q[:, :, :, 0, :].transpose(0, 2, 1, 3)
    q2 = q[:, :, :, 1, :].transpose(0, 2, 1, 3)
    k1 = k[:, :, :, 0, :].transpose(0, 2, 1, 3)
    k2 = k[:, :, :, 1, :].transpose(0, 2, 1, 3)
    vh = v.transpose(0, 2, 1, 3)
    to_blocks = lambda t: t.reshape(B, ATT_HEADS, nblk, QBLK, ATT_DK).transpose(2, 0, 1, 3, 4)
    q1b, q2b = to_blocks(q1), to_blocks(q2)
    kpos = jnp.arange(S)
    slopes = 2.0 ** (-8.0 * (jnp.arange(ATT_HEADS, dtype=jnp.float32) + 1.0) / ATT_HEADS)
    scale = 1.0 / math.sqrt(ATT_DK)

    def attend_block(args):
        qb1, qb2, blk = args
        qpos = blk * QBLK + jnp.arange(QBLK)
        allowed = (kpos // CHUNK)[None, :] <= (qpos // CHUNK)[:, None]
        dist = jnp.abs(qpos[:, None] - kpos[None, :]).astype(jnp.float32)
        bias = -slopes[:, None, None] * dist[None]

        def probs(qb, kk):
            s = jnp.einsum('bhqd,bhkd->bhqk', qb, kk).astype(jnp.float32) * scale + bias
            s = jnp.where(allowed, s, NEG_INF)
            return jax.nn.softmax(s, axis=-1)

        a = probs(qb1, k1) - lam * probs(qb2, k2)
        return jnp.einsum('bhqk,bhkd->bhqd', a.astype(vh.dtype), vh)

    out = lax.map(attend_block, (q1b, q2b, jnp.arange(nblk)))
    out = out.transpose(1, 0, 3, 2, 4).reshape(B, S, ATT_HEADS, ATT_DV)
    of = out.astype(jnp.float32)
    of = of * lax.rsqrt(jnp.mean(of * of, axis=-1, keepdims=True) + RMS_EPS)
    of = of * subln_w.astype(jnp.float32) * (1.0 - lambda_init)
    return of.reshape(B, S, ATT_WIDTH).astype(v.dtype)


def s5_branch(u, a_re, a_im, log_dt, b_re, b_im, c_re, c_im, d_skip, w_glu):
    B, S = u.shape[0], u.shape[1]
    f32 = jnp.float32
    ar, ai = a_re.astype(f32), a_im.astype(f32)
    dt = jnp.exp(log_dt.astype(f32))[:, None]
    mag = jnp.exp(ar * dt)
    ph = ai * dt
    abar_re, abar_im = mag * jnp.cos(ph), mag * jnp.sin(ph)
    nr, ni = abar_re - 1.0, abar_im
    den = ar * ar + ai * ai
    fr = (nr * ar + ni * ai) / den
    fi = (ni * ar - nr * ai) / den
    br, bi = b_re.astype(f32), b_im.astype(f32)
    bbar_re = fr[..., None] * br - fi[..., None] * bi
    bbar_im = fr[..., None] * bi + fi[..., None] * br
    ug = u.astype(f32).reshape(B, S, SSM_GROUPS, SSM_GROUP)
    bu_re = jnp.einsum('bsgh,gph->bsgp', ug, bbar_re)
    bu_im = jnp.einsum('bsgh,gph->bsgp', ug, bbar_im)
    a_re_s = jnp.broadcast_to(abar_re[None, None], (1, S, SSM_GROUPS, SSM_STATE))
    a_im_s = jnp.broadcast_to(abar_im[None, None], (1, S, SSM_GROUPS, SSM_STATE))

    def combine(e1, e2):
        ar1, ai1, br1, bi1 = e1
        ar2, ai2, br2, bi2 = e2
        return (ar2 * ar1 - ai2 * ai1,
                ar2 * ai1 + ai2 * ar1,
                ar2 * br1 - ai2 * bi1 + br2,
                ar2 * bi1 + ai2 * br1 + bi2)

    _, _, xr, xi = lax.associative_scan(combine, (a_re_s, a_im_s, bu_re, bu_im), axis=1)
    y = (jnp.einsum('bsgp,ghp->bsgh', xr, c_re.astype(f32))
         - jnp.einsum('bsgp,ghp->bsgh', xi, c_im.astype(f32)))
    y = y.reshape(B, S, SSM_WIDTH) + d_skip.astype(f32) * u.astype(f32)
    y = jax.nn.gelu(y)
    y = y * jax.nn.sigmoid(y @ w_glu.astype(f32))
    return y.astype(u.dtype)


def setup_inputs(seed: int = 0) -> dict:
    key = jax.random.key(seed)
    ks = jax.random.split(key, 24)
    f32 = jnp.float32
    nrm = lambda k, shape, s: jax.random.normal(k, shape, f32) * s
    x = jax.random.normal(ks[0], (BATCH, SEQ, D_MODEL), f32)
    p = jax.random.normal(ks[1], (DEPTH, BATCH, SEQ, PLE_DIM), f32)
    w_in = nrm(ks[2], (DEPTH, D_MODEL, IN_COLS), D_MODEL ** -0.5)
    w_att_out = nrm(ks[3], (DEPTH, ATT_WIDTH, D_MODEL), BETA * ATT_WIDTH ** -0.5)
    w_ssm_out = nrm(ks[4], (DEPTH, SSM_WIDTH, D_MODEL), BETA * SSM_WIDTH ** -0.5)
    w_out = nrm(ks[5], (DEPTH, D_MODEL, D_MODEL), BETA * D_MODEL ** -0.5)
    w_ple = nrm(ks[6], (DEPTH, PLE_DIM, D_MODEL), PLE_DIM ** -0.5)
    lambda_q1 = nrm(ks[7], (DEPTH, ATT_DK), 0.1)
    lambda_k1 = nrm(ks[8], (DEPTH, ATT_DK), 0.1)
    lambda_q2 = nrm(ks[9], (DEPTH, ATT_DK), 0.1)
    lambda_k2 = nrm(ks[10], (DEPTH, ATT_DK), 0.1)
    subln_w = 1.0 + nrm(ks[11], (DEPTH, ATT_DV), 0.02)
    ssm_a_re = -0.5 + nrm(ks[12], (DEPTH, SSM_GROUPS, SSM_STATE), 0.01)
    ssm_a_im = (math.pi * jnp.arange(SSM_STATE, dtype=f32))[None, None, :] + nrm(ks[13], (DEPTH, SSM_GROUPS, SSM_STATE), 0.01)
    ssm_log_dt = jax.random.uniform(ks[14], (DEPTH, SSM_GROUPS), f32, math.log(1e-3), math.log(1e-1))
    ssm_b_re = nrm(ks[15], (DEPTH, SSM_GROUPS, SSM_STATE, SSM_GROUP), (2.0 * SSM_GROUP) ** -0.5)
    ssm_b_im = nrm(ks[16], (DEPTH, SSM_GROUPS, SSM_STATE, SSM_GROUP), (2.0 * SSM_GROUP) ** -0.5)
    ssm_c_re = nrm(ks[17], (DEPTH, SSM_GROUPS, SSM_GROUP, SSM_STATE), SSM_STATE ** -0.5)
    ssm_c_im = nrm(ks[18], (DEPTH, SSM_GROUPS, SSM_GROUP, SSM_STATE), SSM_STATE ** -0.5)
    ssm_d = nrm(ks[19], (DEPTH, SSM_WIDTH), 1.0)
    ssm_w_glu = nrm(ks[20], (DEPTH, SSM_WIDTH, SSM_WIDTH), SSM_WIDTH ** -0.5)
    ln_g = 1.0 + nrm(ks[21], (DEPTH, D_MODEL), 0.02)
    ln_b = nrm(ks[22], (DEPTH, D_MODEL), 0.02)
    return {"x": x, "p": p, "w_in": w_in, "w_att_out": w_att_out, "w_ssm_out": w_ssm_out,
            "w_out": w_out, "w_ple": w_ple, "lambda_q1": lambda_q1, "lambda_k1": lambda_k1,
            "lambda_q2": lambda_q2, "lambda_k2": lambda_k2, "subln_w": subln_w,
            "ssm_a_re": ssm_a_re, "ssm_a_im": ssm_a_im, "ssm_log_dt": ssm_log_dt,
            "ssm_b_re": ssm_b_re, "ssm_b_im": ssm_b_im, "ssm_c_re": ssm_c_re,
            "ssm_c_im": ssm_c_im, "ssm_d": ssm_d, "ssm_w_glu": ssm_w_glu,
            "ln_g": ln_g, "ln_b": ln_b}


def reference(x, p, w_in, w_att_out, w_ssm_out, w_out, w_ple, lambda_q1, lambda_k1,
              lambda_q2, lambda_k2, subln_w, ssm_a_re, ssm_a_im, ssm_log_dt,
              ssm_b_re, ssm_b_im, ssm_c_re, ssm_c_im, ssm_d, ssm_w_glu, ln_g, ln_b):
    B, S = x.shape[0], x.shape[1]
    for i in range(DEPTH):
        lambda_init = 0.8 - 0.6 * math.exp(-0.3 * i)
        proj = x @ w_in[i]
        q, k, v, z_att, u, z_ssm, g_att, g_ssm, g_ple = jnp.split(proj, SPLIT_POINTS, axis=-1)
        q = q.reshape(B, S, ATT_HEADS, 2, ATT_DK)
        k = k.reshape(B, S, ATT_HEADS, 2, ATT_DK)
        v = v.reshape(B, S, ATT_HEADS, ATT_DV)
        lam = (jnp.exp(jnp.sum(lambda_q1[i].astype(jnp.float32) * lambda_k1[i].astype(jnp.float32)))
               - jnp.exp(jnp.sum(lambda_q2[i].astype(jnp.float32) * lambda_k2[i].astype(jnp.float32)))
               + lambda_init)
        y_att = diff_attention(q, k, v, lam, subln_w[i], lambda_init) * jax.nn.silu(z_att)
        y_ssm = s5_branch(u, ssm_a_re[i], ssm_a_im[i], ssm_log_dt[i], ssm_b_re[i], ssm_b_im[i],
                          ssm_c_re[i], ssm_c_im[i], ssm_d[i], ssm_w_glu[i]) * jax.nn.silu(z_ssm)
        merged = (jax.nn.sigmoid(g_att) * (y_att @ w_att_out[i])
                  + jax.nn.sigmoid(g_ssm) * (y_ssm @ w_ssm_out[i]))
        mixer_out = merged @ w_out[i]
        ple = jax.nn.sigmoid(g_ple) * (p[i] @ w_ple[i])
        x = layer_norm(ALPHA * x + mixer_out + ple, ln_g[i], ln_b[i])
    return x
```

```cpp
#include <hip/hip_runtime.h>
#include <hip/hip_cooperative_groups.h>
#include <cstdio>
#include <cstdint>
namespace cg = cooperative_groups;

#define LAS __attribute__((address_space(3)))
typedef unsigned short bf16_t;
typedef short bf16x8 __attribute__((ext_vector_type(8)));
typedef short s16x4 __attribute__((ext_vector_type(4)));
typedef float f32x4 __attribute__((ext_vector_type(4)));
typedef float f32x2 __attribute__((ext_vector_type(2)));
typedef float f32x16 __attribute__((ext_vector_type(16)));
typedef unsigned u32x4 __attribute__((ext_vector_type(4)));
typedef unsigned u32x2 __attribute__((ext_vector_type(2)));

constexpr int BATCH = 2, SEQ = 16384, DM = 2048, T = BATCH * SEQ, DEPTH = 2;
constexpr int NCOLS = 12288, PLE = 256, AW = 1024, NH = 8;
constexpr int NG = 64, NCH = T / 64;
constexpr float LOG2E = 1.4426950408889634f;
constexpr float QSCALE = 0.125f * LOG2E;
constexpr float ALPHA_RES = 1.4142135623730951f;

constexpr size_t MiB = 1u << 20;
constexpr size_t WS_WIN = 1 * MiB, WS_WAO = 49 * MiB, WS_WSO = 53 * MiB, WS_WOUT = 57 * MiB, WS_WPLE = 65 * MiB, WS_WGLU = 66 * MiB;
constexpr size_t WS_PB = 68 * MiB;
constexpr size_t WS_XLOC = WS_WIN + 16 * MiB;
constexpr size_t WS_Q = 84 * MiB, WS_K = 148 * MiB, WS_VT = 212 * MiB, WS_ZA = 276 * MiB, WS_U = 340 * MiB, WS_ZS = 404 * MiB;
constexpr size_t WS_GA = 468 * MiB, WS_GS = 596 * MiB, WS_GP = 724 * MiB;
constexpr size_t WS_XB = 852 * MiB;
constexpr size_t WS_YG = 852 * MiB, WS_XS = 932 * MiB, WS_YG8 = 940 * MiB;
constexpr size_t WS_KTAB = 980 * MiB, WS_ETAB = 983 * MiB, WS_FTAB = 999 * MiB, WS_A64 = 1015 * MiB;
constexpr unsigned long long FP8_TILES = (0xFull << 12) | (0xFFFFFull << 20), BF16_TILES = 0xFFull | (0xFull << 16) | (0xFFull << 40);
constexpr size_t WS_XB8 = WS_VT;
constexpr size_t WS_END = 1018 * MiB;

constexpr int LDS_BYTES = 147456;

__device__ __forceinline__ unsigned cvt_pk_bf16(float lo, float hi) { unsigned r; asm volatile("v_cvt_pk_bf16_f32 %0, %1, %2" : "=v"(r) : "v"(lo), "v"(hi)); return r; }
typedef __bf16 bf16x2_t __attribute__((ext_vector_type(2)));
__device__ __forceinline__ unsigned cvtpk(float lo, float hi) { f32x2 v = {lo, hi}; bf16x2_t b = __builtin_convertvector(v, bf16x2_t); return __builtin_bit_cast(unsigned, b); }
__device__ __forceinline__ unsigned cvt4_fp8(float a, float b, float c, float d) { int v = 0; v = __builtin_amdgcn_cvt_pk_fp8_f32(a, b, v, false); v = __builtin_amdgcn_cvt_pk_fp8_f32(c, d, v, true); return (unsigned)v; }
__device__ __forceinline__ float bf_lo(unsigned w) { return __uint_as_float(w << 16); }
__device__ __forceinline__ float bf_hi(unsigned w) { return __uint_as_float(w & 0xffff0000u); }
__device__ __forceinline__ float bf1(bf16_t v) { return __uint_as_float(((unsigned)v) << 16); }
__device__ __forceinline__ float ex2(float x) { return __builtin_amdgcn_exp2f(x); }
__device__ __forceinline__ float sigm(float x) { return __builtin_amdgcn_rcpf(1.0f + ex2(-x * LOG2E)); }
__device__ __forceinline__ float silu(float x) { return x * sigm(x); }
__device__ __forceinline__ float gelu_tanh(float y) { const float z = 1.5957691216057308f * (y + 0.044715f * y * y * y); return y * sigm(z); }
__device__ __forceinline__ unsigned* lds_generic_ptr(LAS unsigned* p) { return (unsigned*)p; }
__device__ __forceinline__ float fadd_s(float a, float b) { float r; asm("v_add_f32_e32 %0, %1, %2" : "=v"(r) : "v"(a), "v"(b)); return r; }
__device__ __forceinline__ float fma2_s(float a, float c) { float r; asm("v_fma_f32 %0, %1, 2.0, %2" : "=v"(r) : "v"(a), "v"(c)); return r; }
__device__ __forceinline__ float max3f(float a, float b, float c) { float r; asm("v_max3_f32 %0, %1, %2, %3" : "=v"(r) : "v"(a), "v"(b), "v"(c)); return r; }
__device__ __forceinline__ int crow(int r, int hi) { return (r & 3) + 8 * (r >> 2) + 4 * hi; }

namespace pg8 {
constexpr int BM = 256, BK = 64, HALF = 128, HTB = HALF * BK * 2, STAGE_BYTES = 8 * HTB, NXCD = 8, WGM = 8;
__host__ __device__ __forceinline__ int lds_byte(int r, int c) { const int st = (r >> 4) * 2 + (c >> 5), rr = r & 15, cc = c & 31, ob = rr * 64 + cc * 2; return st * 1024 + (ob ^ (((ob >> 9) & 1) << 5)); }
__host__ __device__ __forceinline__ void stage_rc(int b, int& R, int& C) { const int st = b / 1024, sb = b % 1024, swz = sb ^ (((sb >> 9) & 1) << 5); R = (st >> 1) * 16 + swz / 64; C = (st & 1) * 32 + (swz % 64) / 2; }
__host__ __device__ __forceinline__ int perm32(int rho) { const int n = rho >> 4, i = rho & 15; return 8 * (i >> 2) + 4 * n + (i & 3); }

struct Unit { int pm, pn; };
struct Gemm { const bf16_t* A; const bf16_t* Bt; int M, N, K; int bmul = 1; };

struct StaticOrder {
    int nM, nN, nwg, G, c, wgm = WGM; unsigned long long mask;
    __device__ void init(int M, int N, int G_, int c_, unsigned long long mask_ = 0ull) { nM = M / BM; nN = mask_ ? __builtin_popcountll(mask_) : N / BM; nwg = nM * nN; G = G_; c = c_; mask = mask_; }
    __device__ bool next(int i, Unit& u) const {
        const long L = (long)i * G + c; if (L >= nwg) return false;
        int wgid = (int)L; { const int q = nwg / NXCD, r = nwg % NXCD, xcd = wgid % NXCD, off = wgid / NXCD; wgid = (xcd < r ? xcd * (q + 1) : r * (q + 1) + (xcd - r) * q) + off; }
        const int nig = wgm * nN, gid = wgid / nig, fm = gid * wgm, gsz = (nM - fm) < wgm ? (nM - fm) : wgm;
        u.pm = fm + ((wgid % nig) % gsz); u.pn = (wgid % nig) / gsz; if (mask) { unsigned long long mm = mask; for (int k = 0; k < u.pn; ++k) mm &= mm - 1; u.pn = __builtin_ctzll(mm); } return true;
    }
};

typedef int i32x8 __attribute__((ext_vector_type(8)));
typedef int i32x4 __attribute__((ext_vector_type(4)));
template <class Epi, class Sched, bool FP8 = false>
__device__ __forceinline__ void gemm_phase(LAS unsigned char* lds, const Gemm g, const Sched& S, const Epi& E) {
    int tid = threadIdx.x; asm volatile("" : "+v"(tid));
    const int wid = __builtin_amdgcn_readfirstlane(tid >> 6), lane = tid & 63, wr = wid >> 2, wc = wid & 3, fr = lane & 15, fq = lane >> 4;
    const int K = g.K, nt = K / BK;
    unsigned voffA[2], voffB[2];
#pragma unroll
    for (int i = 0; i < 2; ++i) { int R, C; stage_rc(tid * 16 + i * 8192, R, C); const int Rb = Epi::PERM ? ((R & ~31) + perm32(R & 31)) : R;
        voffA[i] = (unsigned)(R * K + C) * 2u; voffB[i] = (unsigned)(Rb * K + C) * 2u; }
    const size_t kstep = (size_t)(BK * 2);
    const size_t hstep = (size_t)HALF * K * 2;
    const size_t tstep = 2 * hstep;
    const unsigned ldsw = (unsigned)wid * 1024u;
    const int aoff = lds_byte(wr * 64 + fr, fq * 8), boff = lds_byte(wc * 32 + fr, fq * 8);
#define PG8_SA(b, h) (((b) * 2 + (h)) * HTB)
#define PG8_SB(b, h) ((4 + (b) * 2 + (h)) * HTB)
#define PG8_STAGE(bufoff, gbase, voff) do { _Pragma("unroll") for (int _i = 0; _i < 2; ++_i) \
        __builtin_amdgcn_global_load_lds((const unsigned*)((const char*)(gbase) + (voff)[_i]), (LAS unsigned*)(lds + (bufoff) + ldsw + _i * 8192), 16, 0, 0); } while (0)
#define PG8_LDA(dst, b, h) do { _Pragma("unroll") for (int m = 0; m < 4; ++m) _Pragma("unroll") for (int k = 0; k < 2; ++k) dst[m][k] = *(const LAS bf16x8*)(lds + PG8_SA(b, h) + aoff + m * 2048 + k * 1024); } while (0)
#define PG8_LDB(dst, b, h) do { _Pragma("unroll") for (int n = 0; n < 2; ++n) _Pragma("unroll") for (int k = 0; k < 2; ++k) dst[n][k] = *(const LAS bf16x8*)(lds + PG8_SB(b, h) + boff + n * 2048 + k * 1024); } while (0)
#define PG8_CAT(x) __builtin_shufflevector(__builtin_bit_cast(i32x4, (x)[0]), __builtin_bit_cast(i32x4, (x)[1]), 0, 1, 2, 3, 4, 5, 6, 7)
#define PG8_MMA(ai, bj, At, Bt) do { __builtin_amdgcn_s_setprio(1); _Pragma("unroll") for (int m = 0; m < 4; ++m) _Pragma("unroll") for (int n = 0; n < 2; ++n) { \
        if constexpr (FP8) { const i32x8 b8_ = PG8_CAT(Bt[n]), a8_ = PG8_CAT(At[m]);   \
            asm volatile("v_mfma_scale_f32_16x16x128_f8f6f4 %0, %1, %2, %0, %3, %3 op_sel_hi:[0,0,0]" : "+v"(acc[ai][bj][m][n]) : "v"(b8_), "v"(a8_), "v"(one_scale)); } \
        else { _Pragma("unroll") for (int k = 0; k < 2; ++k) acc[ai][bj][m][n] = __builtin_amdgcn_mfma_f32_16x16x32_bf16(Bt[n][k], At[m][k], acc[ai][bj][m][n], 0, 0, 0); } } \
        __builtin_amdgcn_s_setprio(0); } while (0)
#define PG8_WAIT_V(n) asm volatile("s_waitcnt vmcnt(" #n ")" ::: "memory")
#define PG8_WAIT_L(n) asm volatile("s_waitcnt lgkmcnt(" #n ")" ::: "memory")
#define PG8_BAR __builtin_amdgcn_s_barrier()
#define PG8_SCHED __builtin_amdgcn_sched_barrier(0)
    const int one_scale = 0x7f7f7f7f;
    Unit cur, nxt; int ui = 0;
    if (!S.next(0, cur)) return;
    f32x4 acc[2][2][4][2];
#pragma unroll
    for (int a = 0; a < 2; ++a)
#pragma unroll
        for (int b = 0; b < 2; ++b)
#pragma unroll
            for (int m = 0; m < 4; ++m)
#pragma unroll
                for (int n = 0; n < 2; ++n) acc[a][b][m][n] = (f32x4){0.f, 0.f, 0.f, 0.f};
    bf16x8 At[4][2], B0[2][2], B1[2][2];
    const char* cA = (const char*)g.A + (size_t)cur.pm * tstep; const char* cB = (const char*)g.Bt + (size_t)cur.pn * tstep * g.bmul;
    PG8_STAGE(PG8_SB(0, 0), cB, voffB); PG8_STAGE(PG8_SB(0, 1), cB + hstep, voffB); PG8_STAGE(PG8_SA(0, 0), cA, voffA); PG8_STAGE(PG8_SA(0, 1), cA + hstep, voffA);
    if (wr == 1) PG8_BAR;
    PG8_WAIT_V(2); PG8_BAR;
    PG8_STAGE(PG8_SB(1, 0), cB + kstep, voffB); PG8_STAGE(PG8_SA(1, 0), cA + kstep, voffA); PG8_STAGE(PG8_SB(1, 1), cB + hstep + kstep, voffB);
    PG8_WAIT_V(6); PG8_BAR;
    for (;;) {
        const bool has_next = S.next(ui + 1, nxt);
        const char* nA = has_next ? (const char*)g.A + (size_t)nxt.pm * tstep : cA; const char* nB = has_next ? (const char*)g.Bt + (size_t)nxt.pn * tstep * g.bmul : cB;
        for (int t = 0; t < nt; t += 2) {
            const bool last = (t == nt - 2);
            const char* a1 = cA + (size_t)(t + 1) * kstep;
            const char* a2 = last ? nA : cA + (size_t)(t + 2) * kstep; const char* b2 = last ? nB : cB + (size_t)(t + 2) * kstep;
            const char* a3 = a2 + kstep; const char* b3 = b2 + kstep;
            PG8_LDB(B0, 0, 0); PG8_LDB(B1, 0, 1); PG8_SCHED; PG8_LDA(At, 0, 0); PG8_STAGE(PG8_SA(1, 1), a1 + hstep, voffA);
            PG8_WAIT_V(8); PG8_WAIT_L(0); PG8_BAR; PG8_MMA(0, 0, At, B0); PG8_MMA(0, 1, At, B1); PG8_BAR; PG8_SCHED;
            PG8_LDA(At, 0, 1); PG8_STAGE(PG8_SB(0, 0), b2, voffB); PG8_STAGE(PG8_SB(0, 1), b2 + hstep, voffB); PG8_STAGE(PG8_SA(0, 0), a2, voffA);
            PG8_WAIT_V(8); PG8_WAIT_L(0); PG8_BAR; PG8_MMA(1, 0, At, B0); PG8_MMA(1, 1, At, B1); PG8_BAR; PG8_SCHED;
            PG8_LDB(B0, 1, 0); PG8_LDB(B1, 1, 1); PG8_SCHED; PG8_LDA(At, 1, 0); PG8_STAGE(PG8_SA(0, 1), a2 + hstep, voffA);
            PG8_WAIT_V(8); PG8_WAIT_L(0); PG8_BAR; PG8_MMA(0, 0, At, B0); PG8_MMA(0, 1, At, B1); PG8_BAR; PG8_SCHED;
            PG8_LDA(At, 1, 1); PG8_STAGE(PG8_SB(1, 0), b3, voffB); PG8_STAGE(PG8_SB(1, 1), b3 + hstep, voffB); PG8_STAGE(PG8_SA(1, 0), a3, voffA);
            PG8_WAIT_V(8); PG8_WAIT_L(0); PG8_BAR; PG8_MMA(1, 0, At, B0); PG8_MMA(1, 1, At, B1); PG8_BAR; PG8_SCHED;
        }
        if (wr == 0) PG8_BAR;
        if constexpr (FP8) asm volatile("s_nop 15\n\ts_nop 15" ::: "memory");
        if constexpr (Epi::FUSED) E.fused(acc, cur, wr, wc, lds); else E(acc, cur, wr, wc, fr, fq);
        if (!has_next) break;
#pragma unroll
        for (int a = 0; a < 2; ++a)
#pragma unroll
            for (int b = 0; b < 2; ++b)
#pragma unroll
                for (int m = 0; m < 4; ++m)
#pragma unroll
                    for (int n = 0; n < 2; ++n) acc[a][b][m][n] = (f32x4){0.f, 0.f, 0.f, 0.f};
        cur = nxt; cA = nA; cB = nB; ++ui;
        if (wr == 1) PG8_BAR;
    }
    PG8_WAIT_V(0);
    PG8_BAR;
#undef PG8_SA
#undef PG8_SB
#undef PG8_STAGE
#undef PG8_LDA
#undef PG8_LDB
#undef PG8_MMA
#undef PG8_CAT
#undef PG8_WAIT_V
#undef PG8_WAIT_L
#undef PG8_BAR
#undef PG8_SCHED
}
}

enum { EPI_INPROJ = 0, EPI_PLAIN = 1  , EPI_GLU = 2, EPI_MRG_A = 3, EPI_MRG_B = 4, EPI_OUT_A = 5, EPI_OUT_B = 6 };
template <int MODE> struct Epi {
    static constexpr bool PERM = (MODE <= EPI_OUT_A), FUSED = false;
    unsigned char* ws;
    float sc_all;
    bf16_t* O; int ldc;
    const bf16_t* X1;
    const float* res; float* out;
    __device__ __forceinline__ void operator()(const f32x4 (&acc)[2][2][4][2], const pg8::Unit& u, int wr, int wc, int fr_, int fq_) const {
        int t2 = threadIdx.x; asm volatile("" : "+v"(t2)); const int fr = t2 & 15, fq = (t2 >> 4) & 3;
        if constexpr (PERM) {
            bf16_t* base = O; int ld = ldc; int colt = u.pn * 256; float sc = 1.f;
            if constexpr (MODE == EPI_INPROJ) {
                if (u.pn < 24) { base = (bf16_t*)(ws + WS_Q + (size_t)(u.pn >> 2) * (64 * MiB)); ld = 1024; colt = (u.pn & 3) * 256; if (u.pn < 4) sc = QSCALE; }
                else { const int q = u.pn - 24; base = (bf16_t*)(ws + WS_GA + (size_t)(q >> 3) * (128 * MiB)); ld = 2048; colt = (q & 7) * 256; }
                sc *= sc_all;
            }
            const int row0 = u.pm * 256 + wr * 64 + fr, col0 = colt + wc * 32 + 8 * fq;
#pragma unroll
            for (int ai = 0; ai < 2; ++ai)
#pragma unroll
                for (int m = 0; m < 4; ++m) { const size_t roff = (size_t)(row0 + ai * 128 + m * 16) * ld + col0;
#pragma unroll
                    for (int bj = 0; bj < 2; ++bj) { f32x4 v0 = acc[ai][bj][m][0], v1 = acc[ai][bj][m][1]; const size_t off = roff + bj * 128;
                        float v[8] = {v0[0], v0[1], v0[2], v0[3], v1[0], v1[1], v1[2], v1[3]};
                        if constexpr (MODE == EPI_INPROJ) {
#pragma unroll
                            for (int i = 0; i < 8; ++i) v[i] *= sc;
                        }
                        if constexpr (MODE == EPI_GLU) {
                            const u32x4 yg = *(const u32x4*)(X1 + off); const u32x4 zs = *(const u32x4*)(base + off);
#pragma unroll
                            for (int i = 0; i < 4; ++i) { v[2 * i] = bf_lo(yg[i]) * sigm(v[2 * i] * sc_all) * silu(bf_lo(zs[i])); v[2 * i + 1] = bf_hi(yg[i]) * sigm(v[2 * i + 1] * sc_all) * silu(bf_hi(zs[i])); }
                        }
                        if constexpr (MODE == EPI_MRG_A) {
                            const u32x4 ga = *(const u32x4*)(base + off);
#pragma unroll
                            for (int i = 0; i < 4; ++i) { v[2 * i] *= sigm(bf_lo(ga[i])); v[2 * i + 1] *= sigm(bf_hi(ga[i])); }
                        }
                        if constexpr (MODE == EPI_MRG_B) {
                            const u32x4 ga = *(const u32x4*)(base + off); const u32x4 gs = *(const u32x4*)(X1 + off);
#pragma unroll
                            for (int i = 0; i < 4; ++i) { v[2 * i] = bf_lo(ga[i]) + sigm(bf_lo(gs[i])) * v[2 * i]; v[2 * i + 1] = bf_hi(ga[i]) + sigm(bf_hi(gs[i])) * v[2 * i + 1]; }
                        }
                        if constexpr (MODE == EPI_OUT_A) {
                            const f32x4 r0 = *(const f32x4*)(res + off), r1 = *(const f32x4*)(res + off + 4); const u32x4 pl = *(const u32x4*)(X1 + off);
                            f32x4 o0, o1;
                            o0[0] = r0[0] * ALPHA_RES + v[0] + bf_lo(pl[0]); o0[1] = r0[1] * ALPHA_RES + v[1] + bf_hi(pl[0]); o0[2] = r0[2] * ALPHA_RES + v[2] + bf_lo(pl[1]); o0[3] = r0[3] * ALPHA_RES + v[3] + bf_hi(pl[1]);
                            o1[0] = r1[0] * ALPHA_RES + v[4] + bf_lo(pl[2]); o1[1] = r1[1] * ALPHA_RES + v[5] + bf_hi(pl[2]); o1[2] = r1[2] * ALPHA_RES + v[6] + bf_lo(pl[3]); o1[3] = r1[3] * ALPHA_RES + v[7] + bf_hi(pl[3]);
                            *(f32x4*)(out + off) = o0; *(f32x4*)(out + off + 4) = o1;
                            continue;
                        }
                        u32x4 w; w.x = cvt_pk_bf16(v[0], v[1]); w.y = cvt_pk_bf16(v[2], v[3]); w.z = cvt_pk_bf16(v[4], v[5]); w.w = cvt_pk_bf16(v[6], v[7]);
                        if constexpr (MODE == EPI_PLAIN) { const size_t o2 = (off & ~(size_t)15) + 4 * (fq & 1); *(u32x2*)(base + o2) = (u32x2){w.x, w.y}; *(u32x2*)(base + o2 + 8) = (u32x2){w.z, w.w}; }
                        else *(u32x4*)(base + off) = w; } }
        } else {
            const int row0 = u.pm * 256 + wr * 64 + fr, col0 = u.pn * 256 + wc * 32 + 4 * fq;
#pragma unroll
            for (int ai = 0; ai < 2; ++ai)
#pragma unroll
                for (int m = 0; m < 4; ++m) { const size_t roff = (size_t)(row0 + ai * 128 + m * 16) * DM + col0;
#pragma unroll
                    for (int bj = 0; bj < 2; ++bj)
#pragma unroll
                        for (int n = 0; n < 2; ++n) { const size_t off = roff + bj * 128 + n * 16; f32x4 a = acc[ai][bj][m][n];
                            if constexpr (MODE == EPI_OUT_A) { const f32x4 r = *(const f32x4*)(res + off); *(f32x4*)(out + off) = r * ALPHA_RES + a; }
                            else { const u32x2 gp = *(const u32x2*)(X1 + off); f32x4 o = *(const f32x4*)(out + off);
                                o[0] += sigm(bf_lo(gp[0])) * a[0]; o[1] += sigm(bf_hi(gp[0])) * a[1]; o[2] += sigm(bf_lo(gp[1])) * a[2]; o[3] += sigm(bf_hi(gp[1])) * a[3];
                                *(f32x4*)(out + off) = o; } }
                    asm volatile("" ::: "memory"); }
        }
    }
};


__device__ __forceinline__ void transpose_item(const float* W, int K, int N, bf16_t* WT, LAS float* scr, int item, int lane) {
    const int nblk = N / 32, kb = item / nblk, nb = item % nblk, k0 = 64 * kb, n0 = 32 * nb;
    float wv[32];
#pragma unroll
    for (int i = 0; i < 32; ++i) wv[i] = W[(size_t)(k0 + 2 * i + (lane >> 5)) * N + n0 + (lane & 31)];
#pragma unroll
    for (int i = 0; i < 32; ++i) scr[(2 * i + (lane >> 5)) * 33 + (lane & 31)] = wv[i];
    asm volatile("s_waitcnt lgkmcnt(0)" ::: "memory");
    const int c = lane & 7;
#pragma unroll
    for (int j = 0; j < 4; ++j) { const int n = (lane >> 3) + 8 * j; const LAS float* s = scr + (8 * c) * 33 + n;
        u32x4 o; o.x = cvt_pk_bf16(s[0 * 33], s[1 * 33]); o.y = cvt_pk_bf16(s[2 * 33], s[3 * 33]); o.z = cvt_pk_bf16(s[4 * 33], s[5 * 33]); o.w = cvt_pk_bf16(s[6 * 33], s[7 * 33]);
        *(u32x4*)(WT + (size_t)(n0 + n) * K + k0 + 8 * c) = o; }
    asm volatile("s_waitcnt lgkmcnt(0)" ::: "memory");
}

__device__ __forceinline__ void transpose_item_fp8(const float* W, int K, int N, int ncol0, int nblk, unsigned char* WT8, LAS float* scr, int item, int lane) {
    const int kb = item / nblk, nb = item % nblk, k0 = 64 * kb, n0 = 32 * nb;
    float wv[32];
#pragma unroll
    for (int i = 0; i < 32; ++i) wv[i] = W[(size_t)(k0 + 2 * i + (lane >> 5)) * N + ncol0 + n0 + (lane & 31)];
#pragma unroll
    for (int i = 0; i < 32; ++i) scr[(2 * i + (lane >> 5)) * 33 + (lane & 31)] = wv[i];
    asm volatile("s_waitcnt lgkmcnt(0)" ::: "memory");
    const int c = lane & 7;
#pragma unroll
    for (int j = 0; j < 4; ++j) { const int n = (lane >> 3) + 8 * j; const LAS float* s = scr + (8 * c) * 33 + n;
        u32x2 o; o.x = cvt4_fp8(64.f * s[0 * 33], 64.f * s[1 * 33], 64.f * s[2 * 33], 64.f * s[3 * 33]); o.y = cvt4_fp8(64.f * s[4 * 33], 64.f * s[5 * 33], 64.f * s[6 * 33], 64.f * s[7 * 33]);
        *(u32x2*)(WT8 + (size_t)(n0 + n) * K + k0 + 8 * c) = o; }
    asm volatile("s_waitcnt lgkmcnt(0)" ::: "memory");
}

struct Params {
    const float* in[23]; float* out; unsigned char* ws;
};

__device__ __forceinline__ void convert_weights(const Params& P, int li, LAS unsigned char* lds, int gw, int NGW, int lane, int wid, int part = 0) {
    LAS float* scr = (LAS float*)(lds + wid * 16384);
    const float* w_in = P.in[2] + (size_t)li * DM * NCOLS; const float* w_ao = P.in[3] + (size_t)li * AW * DM; const float* w_so = P.in[4] + (size_t)li * AW * DM;
    const float* w_out = P.in[5] + (size_t)li * DM * DM; const float* w_ple = P.in[6] + (size_t)li * PLE * DM; const float* w_glu = P.in[20] + (size_t)li * AW * AW;
    constexpr int I_IN = (DM / 64) * (NCOLS / 32), I_AO = (AW / 64) * (DM / 32), I_OUT = (DM / 64) * (DM / 32), I_PLE = (PLE / 64) * (DM / 32), I_GLU = (AW / 64) * (AW / 32);
    constexpr int NF8 = 24, I_F8 = (DM / 64) * (NF8 * 8);
    constexpr int NITEMS = I_IN + 2 * I_AO + I_OUT + I_PLE + I_GLU + I_F8;
    for (int it = gw; it < NITEMS; it += NGW) {
        int r = it;
        { const bool is_win = (r < I_IN) || (r >= NITEMS - I_F8); if ((part == 1 && !is_win) || (part == 2 && is_win)) continue; }
        if (r >= NITEMS - I_F8) { const int q = r - (NITEMS - I_F8), kb = q / (NF8 * 8), nb = q % (NF8 * 8); unsigned long long mm = FP8_TILES; for (int k = 0; k < (nb >> 3); ++k) mm &= mm - 1; const int pn = __builtin_ctzll(mm);
            transpose_item_fp8(w_in, DM, NCOLS, pn * 256, 8, P.ws + WS_WIN + (size_t)pn * MiB, scr, kb * 8 + (nb & 7), lane); continue; }
        if (r < I_IN) { if (!((FP8_TILES >> ((r % (NCOLS / 32)) >> 3)) & 1ull)) transpose_item(w_in, DM, NCOLS, (bf16_t*)(P.ws + WS_WIN), scr, r, lane); continue; } r -= I_IN;
        if (r < I_AO) { transpose_item(w_ao, AW, DM, (bf16_t*)(P.ws + WS_WAO), scr, r, lane); continue; } r -= I_AO;
        if (r < I_AO) { transpose_item(w_so, AW, DM, (bf16_t*)(P.ws + WS_WSO), scr, r, lane); continue; } r -= I_AO;
        if (r < I_OUT) { transpose_item(w_out, DM, DM, (bf16_t*)(P.ws + WS_WOUT), scr, r, lane); continue; } r -= I_OUT;
        if (r < I_PLE) { transpose_item(w_ple, PLE, DM, (bf16_t*)(P.ws + WS_WPLE), scr, r, lane); continue; } r -= I_PLE;
        transpose_item_fp8(w_glu, AW, AW, 0, AW / 32, P.ws + WS_WGLU, scr, r, lane);
    }
    if (part == 1) return;
    const float* pp = P.in[1] + (size_t)li * T * PLE; bf16_t* pb = (bf16_t*)(P.ws + WS_PB);
    const size_t n8 = (size_t)T * PLE / 8, gt = (size_t)gw * 64 + lane, NT_ = (size_t)NGW * 64;
#pragma unroll 4
    for (size_t i = gt; i < n8; i += NT_) { const f32x4 a = *(const f32x4*)(pp + i * 8), b = *(const f32x4*)(pp + i * 8 + 4);
        u32x4 w; w.x = cvtpk(a[0], a[1]); w.y = cvtpk(a[2], a[3]); w.z = cvtpk(b[0], b[1]); w.w = cvtpk(b[2], b[3]); *(u32x4*)(pb + i * 8) = w; }
}

__device__ __forceinline__ float wave_sum(float v, int lane) {
#pragma unroll
    for (int o = 1; o < 64; o <<= 1) v += __int_as_float(__builtin_amdgcn_ds_bpermute((lane ^ o) << 2, __float_as_int(v)));
    return v;
}
__device__ __forceinline__ float xor32_max(float v) { auto rr = __builtin_amdgcn_permlane32_swap(__float_as_uint(v), __float_as_uint(v), false, false); return fmaxf(__uint_as_float(rr[0]), __uint_as_float(rr[1])); }
__device__ __forceinline__ float xor32_sum(float v) { auto rr = __builtin_amdgcn_permlane32_swap(__float_as_uint(v), __float_as_uint(v), false, false); return __uint_as_float(rr[0]) + __uint_as_float(rr[1]); }

__device__ __forceinline__ void ln_rows(float* h, const float* g, const float* b, bf16_t* xb, unsigned char* xb8, int gw, int NGW, int lane) {
    f32x4 gv[8], bv[8];
#pragma unroll
    for (int j = 0; j < 8; ++j) { gv[j] = *(const f32x4*)(g + 4 * lane + 256 * j); bv[j] = *(const f32x4*)(b + 4 * lane + 256 * j); }
    for (int m = gw; m < T; m += NGW) {
        float* row = h + (size_t)m * DM; f32x4 v[8]; float s = 0.f;
#pragma unroll
        for (int j = 0; j < 8; ++j) { v[j] = *(const f32x4*)(row + 4 * lane + 256 * j); s += (v[j][0] + v[j][1]) + (v[j][2] + v[j][3]); }
        const float mean = wave_sum(s, lane) * (1.f / DM); float s2 = 0.f;
#pragma unroll
        for (int j = 0; j < 8; ++j) { v[j] = v[j] - mean; s2 += (v[j][0] * v[j][0] + v[j][1] * v[j][1]) + (v[j][2] * v[j][2] + v[j][3] * v[j][3]); }
        const float rstd = 1.f / sqrtf(wave_sum(s2, lane) * (1.f / DM) + 1e-5f);
#pragma unroll
        for (int j = 0; j < 8; ++j) { const f32x4 o = v[j] * rstd * gv[j] + bv[j]; *(f32x4*)(row + 4 * lane + 256 * j) = o;
            if (xb) { u32x2 w; w.x = cvt_pk_bf16(o[0], o[1]); w.y = cvt_pk_bf16(o[2], o[3]); *(u32x2*)(xb + (size_t)m * DM + 4 * lane + 256 * j) = w;
                *(unsigned*)(xb8 + (size_t)m * DM + 4 * lane + 256 * j) = cvt4_fp8(o[0], o[1], o[2], o[3]); } }
    }
}

constexpr int LN_LDS = 131072 + 128;
constexpr size_t WS_LNSTAT = 1016 * MiB;
constexpr int CTL_LNCNT = 256;
struct EpiOutLn {
    static constexpr bool PERM = true, FUSED = true;
    const float* res; float* out; const bf16_t* ple; const float* g; const float* b; bf16_t* xb; unsigned char* xb8; unsigned long long* stats; unsigned* cnt;
    __device__ __forceinline__ void fused(f32x4 (&acc)[2][2][4][2], const pg8::Unit& u, int wr, int wc, LAS unsigned char* lds) const {
        int t2 = threadIdx.x; asm volatile("" : "+v"(t2));
        const int lane = t2 & 63, fr = t2 & 15, fq = (t2 >> 4) & 3, wid = __builtin_amdgcn_readfirstlane(t2 >> 6);
        LAS float* rs = (LAS float*)(lds + LN_LDS); LAS float* tab = rs + 2048;
        const int row0 = u.pm * 256 + wr * 64 + fr, col0 = u.pn * 256 + wc * 32 + 8 * fq;
#pragma unroll
        for (int ai = 0; ai < 2; ++ai)
#pragma unroll
            for (int m = 0; m < 4; ++m) { const size_t roff = (size_t)(row0 + ai * 128 + m * 16) * DM + col0; float s1 = 0.f, s2 = 0.f;
#pragma unroll
                for (int bj = 0; bj < 2; ++bj) { const size_t off = roff + bj * 128;
                    const f32x4 r0 = *(const f32x4*)(res + off), r1 = *(const f32x4*)(res + off + 4); const u32x4 pl = *(const u32x4*)(ple + off);
                    f32x4 h0 = acc[ai][bj][m][0], h1 = acc[ai][bj][m][1];
                    h0[0] += r0[0] * ALPHA_RES + bf_lo(pl[0]); h0[1] += r0[1] * ALPHA_RES + bf_hi(pl[0]); h0[2] += r0[2] * ALPHA_RES + bf_lo(pl[1]); h0[3] += r0[3] * ALPHA_RES + bf_hi(pl[1]);
                    h1[0] += r1[0] * ALPHA_RES + bf_lo(pl[2]); h1[1] += r1[1] * ALPHA_RES + bf_hi(pl[2]); h1[2] += r1[2] * ALPHA_RES + bf_lo(pl[3]); h1[3] += r1[3] * ALPHA_RES + bf_hi(pl[3]);
                    acc[ai][bj][m][0] = h0; acc[ai][bj][m][1] = h1;
                    s1 += (h0[0] + h0[1]) + (h0[2] + h0[3]) + (h1[0] + h1[1]) + (h1[2] + h1[3]);
                    s2 += (h0[0] * h0[0] + h0[1] * h0[1]) + (h0[2] * h0[2] + h0[3] * h0[3]) + (h1[0] * h1[0] + h1[1] * h1[1]) + (h1[2] * h1[2] + h1[3] * h1[3]); }
                s1 += __int_as_float(__builtin_amdgcn_ds_bpermute((lane ^ 16) << 2, __float_as_int(s1))); s2 += __int_as_float(__builtin_amdgcn_ds_bpermute((lane ^ 16) << 2, __float_as_int(s2)));
                s1 = xor32_sum(s1); s2 = xor32_sum(s2);
                if (fq == 0) { const int r = ai * 128 + wr * 64 + m * 16 + fr; rs[(r * 4 + wc) * 2] = s1; rs[(r * 4 + wc) * 2 + 1] = s2; }
                asm volatile("" ::: "memory"); }
        asm volatile("s_waitcnt lgkmcnt(0)" ::: "memory"); __builtin_amdgcn_s_barrier(); asm volatile("" ::: "memory");
        if (t2 < 256) { const int r = t2; const float a = (rs[(r * 4) * 2] + rs[(r * 4 + 1) * 2]) + (rs[(r * 4 + 2) * 2] + rs[(r * 4 + 3) * 2]);
            const float q = (rs[(r * 4) * 2 + 1] + rs[(r * 4 + 1) * 2 + 1]) + (rs[(r * 4 + 2) * 2 + 1] + rs[(r * 4 + 3) * 2 + 1]);
            __hip_atomic_store(stats + ((size_t)(u.pm * 256 + r) * 8 + u.pn), ((unsigned long long)__float_as_uint(q) << 32) | __float_as_uint(a), __ATOMIC_RELAXED, __HIP_MEMORY_SCOPE_AGENT); }
        asm volatile("s_waitcnt vmcnt(0)" ::: "memory");
        if (t2 < 256 && lane == 0) __hip_atomic_fetch_add(cnt + u.pm, 1u, __ATOMIC_RELAXED, __HIP_MEMORY_SCOPE_AGENT);
        if (wid == 0) { unsigned sp = 0;
            while ((unsigned)__builtin_amdgcn_readfirstlane(__hip_atomic_load(cnt + u.pm, __ATOMIC_RELAXED, __HIP_MEMORY_SCOPE_AGENT)) < 32u) { __builtin_amdgcn_s_sleep(2); if (++sp > (1u << 22)) break; }
            __builtin_amdgcn_fence(__ATOMIC_ACQUIRE, "agent"); asm volatile("s_waitcnt vmcnt(0)" ::: "memory"); }
        asm volatile("s_waitcnt lgkmcnt(0)" ::: "memory"); __builtin_amdgcn_s_barrier(); asm volatile("" ::: "memory");
        if (t2 < 256) { const int r = t2; const unsigned long long* sl_ = stats + (size_t)(u.pm * 256 + r) * 8; float a = 0.f, q = 0.f;
#pragma unroll
            for (int k = 0; k < 8; ++k) { const unsigned long long w = __hip_atomic_load(sl_ + k, __ATOMIC_RELAXED, __HIP_MEMORY_SCOPE_AGENT); a += __uint_as_float((unsigned)w); q += __uint_as_float((unsigned)(w >> 32)); }
            const float mean = a * (1.f / DM), var = q * (1.f / DM) - mean * mean; tab[r * 2] = mean; tab[r * 2 + 1] = 1.f / sqrtf(fmaxf(var, 0.f) + 1e-5f); }
        asm volatile("s_waitcnt lgkmcnt(0)" ::: "memory"); __builtin_amdgcn_s_barrier(); asm volatile("" ::: "memory");
#pragma unroll
        for (int bj = 0; bj < 2; ++bj) { const int c = col0 + bj * 128;
            const f32x4 g0 = *(const f32x4*)(g + c), g1 = *(const f32x4*)(g + c + 4), b0 = *(const f32x4*)(b + c), b1 = *(const f32x4*)(b + c + 4);
#pragma unroll
            for (int ai = 0; ai < 2; ++ai)
#pragma unroll
                for (int m = 0; m < 4; ++m) { const int r = ai * 128 + wr * 64 + m * 16 + fr; const float mean = tab[r * 2], rstd = tab[r * 2 + 1];
                    const size_t off = (size_t)(u.pm * 256 + r) * DM + c;
                    const f32x4 o0 = (acc[ai][bj][m][0] - mean) * rstd * g0 + b0, o1 = (acc[ai][bj][m][1] - mean) * rstd * g1 + b1;
                    *(f32x4*)(out + off) = o0; *(f32x4*)(out + off + 4) = o1;
                    if (xb) { u32x4 w; w.x = cvtpk(o0[0], o0[1]); w.y = cvtpk(o0[2], o0[3]); w.z = cvtpk(o1[0], o1[1]); w.w = cvtpk(o1[2], o1[3]); *(u32x4*)(xb + off) = w;
                        *(u32x2*)(xb8 + off) = (u32x2){cvt4_fp8(o0[0], o0[1], o0[2], o0[3]), cvt4_fp8(o1[0], o1[1], o1[2], o1[3])}; }
                    asm volatile("" ::: "memory"); } }
    }
};

__device__ __forceinline__ void ssm_tables(const Params& P, int li, LAS unsigned char* lds, int item) {
    int tid = threadIdx.x; asm volatile("" : "+v"(tid));
    const int g = item >> 2, part = item & 3;
    LAS float* zre = (LAS float*)lds; LAS float* zim = zre + 65 * 64;
    LAS float* bre = zim + 65 * 64; LAS float* bim = bre + 1024;
    LAS float* cre = bim + 1024; LAS float* cim = cre + 1024;
    const float* a_re = P.in[12] + (size_t)li * NG * 64 + g * 64; const float* a_im = P.in[13] + (size_t)li * NG * 64 + g * 64;
    const float dt = expf(P.in[14][li * NG + g]);
    const float* b_re = P.in[15] + ((size_t)li * NG + g) * 1024; const float* b_im = P.in[16] + ((size_t)li * NG + g) * 1024;
    const float* c_re = P.in[17] + ((size_t)li * NG + g) * 1024; const float* c_im = P.in[18] + ((size_t)li * NG + g) * 1024;
    __syncthreads();
    for (int idx = tid; idx < 1024; idx += 512) {
        const int p = idx >> 4;
        const float ar = a_re[p], ai = a_im[p]; const float mag = expf(ar * dt), ph = ai * dt; float sn, cs; sincosf(ph, &sn, &cs);
        const float abr = mag * cs, abi = mag * sn, nr = abr - 1.0f, ni = abi, den = ar * ar + ai * ai;
        const float fr = (nr * ar + ni * ai) / den, fi = (ni * ar - nr * ai) / den;
        const float br = b_re[idx], bi = b_im[idx];
        bre[idx] = fr * br - fi * bi; bim[idx] = fr * bi + fi * br;
        cre[idx] = c_re[idx]; cim[idx] = c_im[idx];
        if ((idx & 15) == 0) {
            float zr = 1.f, zi = 0.f;
            for (int t = 0; t <= 64; ++t) { zre[t * 64 + p] = zr; zim[t * 64 + p] = zi; const float nzr = zr * abr - zi * abi, nzi = zr * abi + zi * abr; zr = nzr; zi = nzi; }
            if (part == 0) { float* a64 = (float*)(P.ws + WS_A64) + (g * 64 + p) * 2; a64[0] = zre[64 * 64 + p]; a64[1] = zim[64 * 64 + p]; }
        }
    }
    __syncthreads();
    bf16_t* ktab = (bf16_t*)(P.ws + WS_KTAB) + (size_t)g * 65 * 256;
    if (part == 0 && tid < 256) ktab[64 * 256 + tid] = 0;
    for (int e = tid; e < 16 * 256; e += 512) {
        const int tau = part * 16 + (e >> 8), h = (e >> 4) & 15, h2 = e & 15; float s = 0.f;
        for (int p = 0; p < 64; ++p) { const float zr = zre[tau * 64 + p], zi = zim[tau * 64 + p], cr = cre[h * 64 + p], ci = cim[h * 64 + p];
            const float czr = cr * zr - ci * zi, czi = cr * zi + ci * zr; s += czr * bre[p * 16 + h2] - czi * bim[p * 16 + h2]; }
        ktab[tau * 256 + h * 16 + h2] = (bf16_t)(cvt_pk_bf16(s, 0.f) & 0xffff);
    }
    bf16_t* etab = (bf16_t*)(P.ws + WS_ETAB) + (size_t)g * 1024 * 128;
    for (int e = tid; e < 256 * 128; e += 512) {
        const int row = part * 256 + (e >> 7), col = e & 127, t = row >> 4, h = row & 15, p = col >> 1;
        const float zr = zre[(t + 1) * 64 + p], zi = zim[(t + 1) * 64 + p], cr = cre[h * 64 + p], ci = cim[h * 64 + p];
        const float v = (col & 1) ? -(cr * zi + ci * zr) : (cr * zr - ci * zi);
        etab[(size_t)row * 128 + col] = (bf16_t)(cvt_pk_bf16(v, 0.f) & 0xffff);
    }
    bf16_t* ftab = (bf16_t*)(P.ws + WS_FTAB) + (size_t)g * 128 * 1024;
    for (int e = tid; e < 128 * 256; e += 512) {
        const int row = e >> 8, col = part * 256 + (e & 255), p = row >> 1, s = col >> 4, h2 = col & 15;
        const float zr = zre[(63 - s) * 64 + p], zi = zim[(63 - s) * 64 + p], br = bre[p * 16 + h2], bi = bim[p * 16 + h2];
        const float v = (row & 1) ? (zr * bi + zi * br) : (zr * br - zi * bi);
        ftab[(size_t)row * 1024 + col] = (bf16_t)(cvt_pk_bf16(v, 0.f) & 0xffff);
    }
    __syncthreads();
}

__device__ __forceinline__ void ssm_local(const Params& P, int item, int lane) {
    const int rt = item & 3, cg_ = (item >> 2) & 15, g = item >> 6, r32 = lane & 31, hi = lane >> 5;
    const bf16_t* F = (const bf16_t*)(P.ws + WS_FTAB) + ((size_t)g * 128 + rt * 32 + r32) * 1024 + hi * 8;
    const bf16_t* U = (const bf16_t*)(P.ws + WS_U) + ((size_t)(cg_ * 32 + r32) * 64) * 1024 + g * 16 + hi * 8;
    f32x16 acc = {};
#pragma unroll 16
    for (int s = 0; s < 64; ++s) { const bf16x8 a = *(const bf16x8*)(F + s * 16); const bf16x8 b = *(const bf16x8*)(U + (size_t)s * 1024);
        acc = __builtin_amdgcn_mfma_f32_32x32x16_bf16(a, b, acc, 0, 0, 0); }
    float* xl = (float*)(P.ws + WS_XLOC) + ((size_t)(cg_ * 32 + r32) * 64 + g) * 128 + rt * 32 + 4 * hi;
#pragma unroll
    for (int q = 0; q < 4; ++q) *(f32x4*)(xl + 8 * q) = (f32x4){acc[4 * q], acc[4 * q + 1], acc[4 * q + 2], acc[4 * q + 3]};
}

__device__ __forceinline__ void ssm_scan(const Params& P, int gt) {
    const int b = gt >> 12, g = (gt >> 6) & 63, p = gt & 63;
    const f32x2 a = *(const f32x2*)((const float*)(P.ws + WS_A64) + (g * 64 + p) * 2);
    const float* xl = (const float*)(P.ws + WS_XLOC) + ((size_t)(b * 256) * 64 + g) * 128 + 2 * p;
    unsigned* xs = (unsigned*)((bf16_t*)(P.ws + WS_XS) + ((size_t)(b * 256) * 64 + g) * 128 + 2 * p);
    float xr = 0.f, xi = 0.f;
#pragma unroll 32
    for (int c = 0; c < 256; ++c) {
        const f32x2 l = *(const f32x2*)(xl + (size_t)c * 64 * 128);
        xs[(size_t)c * 64 * 64] = cvt_pk_bf16(xr, xi);
        const float nr = a[0] * xr - a[1] * xi + l[0], ni = a[0] * xi + a[1] * xr + l[1]; xr = nr; xi = ni;
    }
}

constexpr int SY_KT = 0, SY_U = 65 * 512, SY_UP = 2064;
__device__ __forceinline__ void ssm_y_unit(const Params& P, int li, LAS unsigned char* lds, int unit, bool stage_k) {
    int tid = threadIdx.x; asm volatile("" : "+v"(tid));
    const int g = unit >> 4, cg_ = unit & 15, lane = tid & 63, wid = __builtin_amdgcn_readfirstlane(tid >> 6), r32 = lane & 31, hi = lane >> 5;
    __syncthreads();
    {
        const u32x4* src = (const u32x4*)((const bf16_t*)(P.ws + WS_KTAB) + (size_t)g * 65 * 256);
        if (stage_k) for (int i = tid; i < 2080; i += 512) *(LAS u32x4*)(lds + SY_KT + i * 16) = src[i];
        const bf16_t* U = (const bf16_t*)(P.ws + WS_U);
        for (int i = tid; i < 4096; i += 512) { const int c = i >> 7, s = (i >> 1) & 63, hf = i & 1;
            const u32x4 v = *(const u32x4*)(U + ((size_t)((cg_ * 32 + c) * 64 + s)) * 1024 + g * 16 + hf * 8);
            *(LAS u32x4*)(lds + SY_U + c * SY_UP + s * 32 + hf * 16) = v; }
    }
    bf16x8 xsf[8];
    { const bf16_t* xs = (const bf16_t*)(P.ws + WS_XS) + ((size_t)(cg_ * 32 + r32) * 64 + g) * 128 + hi * 8;
#pragma unroll
      for (int k = 0; k < 8; ++k) xsf[k] = *(const bf16x8*)(xs + k * 16); }
    __syncthreads();
    const float* dsk = P.in[19] + (size_t)li * 1024 + g * 16;
    const int hrow = r32 & 15, trow = r32 >> 4;
    for (int j = 0; j < 4; ++j) {
        const int ti = (j == 0) ? wid : (j == 1) ? 15 - wid : (j == 2) ? 16 + wid : 31 - wid;
        f32x16 acc = {};
        const int ns = 2 * ti + 2;
        const LAS unsigned char* ub = lds + SY_U + r32 * SY_UP + hi * 16;
        const LAS unsigned char* kb = lds + SY_KT + hrow * 32 + hi * 16;
        f32x16 acc2 = {};
        for (int s = 0; s < ns; s += 2) {
            int tau = 2 * ti + trow - s; const int tau0 = tau < 0 ? 64 : tau, tau1 = tau - 1 < 0 ? 64 : tau - 1;
            const bf16x8 a0 = *(const LAS bf16x8*)(kb + tau0 * 512), a1 = *(const LAS bf16x8*)(kb + tau1 * 512);
            const bf16x8 b0 = *(const LAS bf16x8*)(ub + s * 32), b1 = *(const LAS bf16x8*)(ub + s * 32 + 32);
            acc = __builtin_amdgcn_mfma_f32_32x32x16_bf16(a0, b0, acc, 0, 0, 0);
            acc2 = __builtin_amdgcn_mfma_f32_32x32x16_bf16(a1, b1, acc2, 0, 0, 0);
        }
        const bf16_t* E = (const bf16_t*)(P.ws + WS_ETAB) + ((size_t)g * 1024 + ti * 32 + r32) * 128 + hi * 8;
#pragma unroll
        for (int k = 0; k < 8; k += 2) { const bf16x8 a0 = *(const bf16x8*)(E + k * 16), a1 = *(const bf16x8*)(E + k * 16 + 16);
            acc = __builtin_amdgcn_mfma_f32_32x32x16_bf16(a0, xsf[k], acc, 0, 0, 0); acc2 = __builtin_amdgcn_mfma_f32_32x32x16_bf16(a1, xsf[k + 1], acc2, 0, 0, 0); }
        acc += acc2;
        bf16_t* yg = (bf16_t*)(P.ws + WS_YG);
#pragma unroll
        for (int q = 0; q < 4; ++q) {
            const int row = 8 * q + 4 * hi, t = 2 * ti + (row >> 4), h0 = row & 15;
            const u32x2 uu = *(const LAS u32x2*)(lds + SY_U + r32 * SY_UP + t * 32 + h0 * 2);
            const f32x4 d4 = *(const f32x4*)(dsk + h0);
            float y0 = acc[4 * q] + d4[0] * bf_lo(uu[0]), y1 = acc[4 * q + 1] + d4[1] * bf_hi(uu[0]), y2 = acc[4 * q + 2] + d4[2] * bf_lo(uu[1]), y3 = acc[4 * q + 3] + d4[3] * bf_hi(uu[1]);
            const float g0 = gelu_tanh(y0), g1 = gelu_tanh(y1), g2 = gelu_tanh(y2), g3 = gelu_tanh(y3);
            u32x2 w; w.x = cvt_pk_bf16(g0, g1); w.y = cvt_pk_bf16(g2, g3);
            const size_t yo = ((size_t)((cg_ * 32 + r32) * 64 + t)) * 1024 + g * 16 + h0;
            *(u32x2*)(yg + yo) = w; *(unsigned*)(P.ws + WS_YG8 + yo) = cvt4_fp8(g0, g1, g2, g3);
        }
    }
}

constexpr int AT_STG = 32768, AT_NST = 4;
constexpr int AT_CTL = AT_NST * AT_STG;
constexpr float AT_DEFER = 8.f;
constexpr float AT_MASS = 26.f;
constexpr int CTL_KMAX = 0, CTL_QCTR = 64;
__device__ __forceinline__ void kmax_task(const Params& P, int task, int lane) {
    const int chunk = task >> 4, hm = task & 15; const size_t token = (size_t)chunk * 64 + lane;
    const u32x4* kp = (const u32x4*)((const bf16_t*)(P.ws + WS_K) + token * 1024 + hm * 64);
    float ss = 0.f;
#pragma unroll
    for (int i = 0; i < 8; ++i) { const u32x4 v = kp[i];
#pragma unroll
        for (int j = 0; j < 4; ++j) { const float a = bf_lo(v[j]), b2 = bf_hi(v[j]); ss += a * a + b2 * b2; } }
#pragma unroll
    for (int o = 1; o < 64; o <<= 1) ss = fmaxf(ss, __int_as_float(__builtin_amdgcn_ds_bpermute((lane ^ o) << 2, __float_as_int(ss))));
    if (lane == 0) atomicMax((unsigned*)P.ws + CTL_KMAX + (chunk >> 8) * 16 + hm, __float_as_uint(ss));
}
__device__ __forceinline__ void attn_unit(const Params& P, int li, LAS unsigned char* lds, int b, int h, int qb, float lam, float one_m_li) {
    int tid = threadIdx.x; asm volatile("" : "+v"(tid));
    const int lane = tid & 63, wid = __builtin_amdgcn_readfirstlane(tid >> 6), r32 = lane & 31, hi = lane >> 5, mp = wid >> 2, wq = wid & 3;
    const bf16_t* Qg = (const bf16_t*)(P.ws + WS_Q); const bf16_t* Kg = (const bf16_t*)(P.ws + WS_K); const bf16_t* VTg = (const bf16_t*)(P.ws + WS_VT);
    const int NT = qb * 2 + 2, cw = qb * 2 + (wq >> 1);
    const float sl = __uint_as_float((unsigned)(127 - (h + 1)) << 23) * LOG2E;
    const float sl3 = 3.f * sl, sl8 = 8.f * sl, sl24 = 24.f * sl, sl32 = 32.f * sl;
    const float thr = AT_MASS - __builtin_amdgcn_logf(1.0f - ex2(-sl)) + 0.01f;
    const int qpos = qb * 128 + wq * 32 + r32;
    const size_t tok = (size_t)b * SEQ + qpos;
    const float qinf = (float)((wq & 1) * 32 + r32) - 4.f * (float)hi;
    const int srow = wid * 8 + (lane >> 3), lch = (lane & 7) ^ ((srow >> 1) & 7);
    const bf16_t* kg0 = Kg + ((size_t)b * SEQ + srow) * 1024 + h * 128 + lch * 8;
    const bf16_t* vg0 = VTg + ((size_t)(h * 128 + srow)) * T + (size_t)b * SEQ + lch * 8;
    const unsigned ldsw = (unsigned)wid * 1024u;
#define AT_ISSUE(t_, st_) do { LAS unsigned char* sb_ = lds + (st_) * AT_STG + ldsw; \
        __builtin_amdgcn_global_load_lds((const unsigned*)(kg0 + (size_t)(t_) * 65536), (LAS unsigned*)(sb_), 16, 0, 0); \
        __builtin_amdgcn_global_load_lds((const unsigned*)(kg0 + (size_t)(t_) * 65536 + 64), (LAS unsigned*)(sb_ + 8192), 16, 0, 0); \
        __builtin_amdgcn_global_load_lds((const unsigned*)(vg0 + (t_) * 64), (LAS unsigned*)(sb_ + 16384), 16, 0, 0); \
        __builtin_amdgcn_global_load_lds((const unsigned*)(vg0 + (size_t)64 * T + (t_) * 64), (LAS unsigned*)(sb_ + 24576), 16, 0, 0); } while (0)
    LAS unsigned* ctl = (LAS unsigned*)(lds + AT_CTL);
    if (tid == 0) ctl[0] = 0x7fffffffu;
    bf16x8 qr[4];
#pragma unroll
    for (int d0 = 0; d0 < 4; ++d0) qr[d0] = *(const bf16x8*)(Qg + tok * 1024 + h * 128 + mp * 64 + d0 * 16 + hi * 8);
    asm volatile("" ::: "memory");
    AT_ISSUE(NT - 1, 0); AT_ISSUE(NT - 2, 1);
    float qn;
    { float s2 = 0.f;
#pragma unroll
      for (int d0 = 0; d0 < 4; ++d0)
#pragma unroll
          for (int j = 0; j < 8; ++j) { const float v = bf1((bf16_t)qr[d0][j]); s2 += v * v; }
      qn = sqrtf(xor32_sum(s2)); }
    const float kmx = sqrtf(__uint_as_float(__hip_atomic_load((unsigned*)P.ws + CTL_KMAX + b * 16 + h * 2 + mp, __ATOMIC_RELAXED, __HIP_MEMORY_SCOPE_AGENT)));
    const int sw = (r32 >> 1) & 7;
    int coff[4];
#pragma unroll
    for (int k = 0; k < 4; ++k) coff[k] = ((2 * k + hi) ^ sw) << 4;
    f32x16 o[4]; o[0] = f32x16{}; o[1] = f32x16{}; o[2] = f32x16{}; o[3] = f32x16{};
    float m = -1e30f, l = 0.f;
    bf16x8 pf[4];
    bool havepf = false;
#define AT_EXP(r_) do { p0[r_] = ex2(p0[r_]); p1[r_] = ex2(p1[r_]); lsa[(r_) & 1] = fadd_s(lsa[(r_) & 1], p0[r_]); lsb[(r_) & 1] = fadd_s(lsb[(r_) & 1], p1[r_]); } while (0)
#define AT_PACK() do { _Pragma("unroll") for (int s = 0; s < 2; ++s) { u32x4 w0, w1; \
            w0.x = cvtpk(p0[8 * s], p0[8 * s + 1]); w0.y = cvtpk(p0[8 * s + 2], p0[8 * s + 3]); w0.z = cvtpk(p0[8 * s + 4], p0[8 * s + 5]); w0.w = cvtpk(p0[8 * s + 6], p0[8 * s + 7]); \
            w1.x = cvtpk(p1[8 * s], p1[8 * s + 1]); w1.y = cvtpk(p1[8 * s + 2], p1[8 * s + 3]); w1.z = cvtpk(p1[8 * s + 4], p1[8 * s + 5]); w1.w = cvtpk(p1[8 * s + 6], p1[8 * s + 7]); \
            pf[s] = __builtin_bit_cast(bf16x8, w0); pf[2 + s] = __builtin_bit_cast(bf16x8, w1); } } while (0)
    asm volatile("s_waitcnt vmcnt(0) lgkmcnt(0)" ::: "memory"); __builtin_amdgcn_s_barrier(); asm volatile("" ::: "memory");
    int iend = NT, i = 0;
#pragma unroll 1
    for (; i < iend; ++i) {
        const int t = NT - 1 - i;
        asm volatile("s_waitcnt vmcnt(0) lgkmcnt(0)" ::: "memory");
        __builtin_amdgcn_s_barrier();
        asm volatile("" ::: "memory");
        if (i == 2) { const int tstop = (int)ctl[0]; const int ie = NT - (tstop < NT - 2 ? tstop : NT - 2); iend = ie; if (i >= ie) break; }
        if (t >= 2) AT_ISSUE(t - 2, (i + 2) & 3);
        const LAS unsigned char* cb = lds + (i & 3) * AT_STG;
        if (t <= cw) {
            f32x16 p0, p1;
            const LAS unsigned char* kp = cb + mp * 8192 + r32 * 128;
            bf16x8 kf[8];
#pragma unroll
            for (int d0 = 0; d0 < 4; ++d0) { kf[2 * d0] = *(const LAS bf16x8*)(kp + coff[d0]); kf[2 * d0 + 1] = *(const LAS bf16x8*)(kp + 4096 + coff[d0]); }
            const bool diag = (t == cw);
            if (diag) { p0 = f32x16{}; p1 = f32x16{}; }
            else {
                const float nc0 = -(sl * ((float)((cw - t) * 64) + qinf) + m), nc1 = fadd_s(nc0, sl32);
                float b0[4], b1[4];
                b0[0] = nc0; b0[1] = fadd_s(nc0, sl8); b0[2] = fma2_s(sl8, nc0); b0[3] = fadd_s(nc0, sl24);
                b1[0] = nc1; b1[1] = fadd_s(nc1, sl8); b1[2] = fma2_s(sl8, nc1); b1[3] = fadd_s(nc1, sl24);
#pragma unroll
                for (int q = 0; q < 4; ++q) {
                    p0[4 * q] = b0[q]; p0[4 * q + 1] = fadd_s(b0[q], sl); p0[4 * q + 2] = fma2_s(sl, b0[q]); p0[4 * q + 3] = fadd_s(b0[q], sl3);
                    p1[4 * q] = b1[q]; p1[4 * q + 1] = fadd_s(b1[q], sl); p1[4 * q + 2] = fma2_s(sl, b1[q]); p1[4 * q + 3] = fadd_s(b1[q], sl3);
                }
            }
            __builtin_amdgcn_sched_barrier(0);
            __builtin_amdgcn_s_setprio(1);
#pragma unroll
            for (int d0 = 0; d0 < 4; ++d0) {
                p0 = __builtin_amdgcn_mfma_f32_32x32x16_bf16(kf[2 * d0], qr[d0], p0, 0, 0, 0);
                p1 = __builtin_amdgcn_mfma_f32_32x32x16_bf16(kf[2 * d0 + 1], qr[d0], p1, 0, 0, 0);
            }
            __builtin_amdgcn_s_setprio(0);
            if (diag) {
                float qf = qinf; asm volatile("" : "+v"(qf));
#pragma unroll
                for (int r = 0; r < 16; ++r) { const float d0 = qf - (float)crow(r, 0);
                    p0[r] = fmaf(-sl, fabsf(d0), p0[r]); p1[r] = fmaf(-sl, fabsf(d0 - 32.f), p1[r]); }
            }
            float mx = max3f(p0[0], p1[0], p0[1]);
#pragma unroll
            for (int r = 1; r < 15; ++r) mx = max3f(mx, p1[r], p0[r + 1]);
            mx = max3f(mx, p1[15], mx);
            const float mt = xor32_max(mx);
            bool resc; float ra;
            if (diag) {
                resc = true; ra = ex2(m - mt); m = mt;
#pragma unroll
                for (int r = 0; r < 16; ++r) { p0[r] -= mt; p1[r] -= mt; }
                const float X = qn * kmx - m + thr; const float ts = floorf(((float)(qpos - 63) - X / sl) * (1.f / 64.f));
                const unsigned tsu = ts > 0.f ? (unsigned)ts : 0u; __hip_atomic_fetch_min(ctl, tsu, __ATOMIC_RELAXED, __HIP_MEMORY_SCOPE_WORKGROUP);
            } else {
                resc = __any(mt > AT_DEFER); ra = 1.f;
                if (resc) {
                    const float dl = fmaxf(mt, 0.f); ra = ex2(-dl); m += dl;
#pragma unroll
                    for (int r = 0; r < 16; ++r) { p0[r] -= dl; p1[r] -= dl; }
                }
            }
            float lsa[2] = {0.f, 0.f}, lsb[2] = {0.f, 0.f};
            if (havepf) {
                const LAS unsigned char* vp = lds + ((i + 3) & 3) * AT_STG + 16384 + r32 * 128;
                asm volatile("" : "+v"(p0), "+v"(p1));
                bf16x8 va[2][2];
#pragma unroll
                for (int d = 0; d < 2; ++d) va[0][d] = *(const LAS bf16x8*)(vp + d * 4096 + coff[0]);
#pragma unroll
                for (int g = 0; g < 8; ++g) {
                    if (g + 1 < 8) {
#pragma unroll
                        for (int d = 0; d < 2; ++d) va[(g + 1) & 1][d] = *(const LAS bf16x8*)(vp + (((g + 1) & 1) * 2 + d) * 4096 + coff[((g + 1) >> 1) & 3]);
                    }
#pragma unroll
                    for (int d = 0; d < 2; ++d) o[(g & 1) * 2 + d] = __builtin_amdgcn_mfma_f32_32x32x16_bf16(va[g & 1][d], pf[g >> 1], o[(g & 1) * 2 + d], 0, 0, 0);
                    AT_EXP(2 * g); AT_EXP(2 * g + 1);
                    __builtin_amdgcn_sched_barrier(0);
                }
            } else {
#pragma unroll
                for (int r = 0; r < 16; ++r) AT_EXP(r);
            }
            AT_PACK();
            if (resc) { l *= ra;
#pragma unroll
                for (int d = 0; d < 4; ++d) o[d] *= ra; }
            l += (lsa[0] + lsa[1]) + (lsb[0] + lsb[1]);
            havepf = true;
        }
    }
    if (havepf) {
        const LAS unsigned char* vp = lds + ((i + 3) & 3) * AT_STG + 16384 + r32 * 128;
#pragma unroll
        for (int ks = 0; ks < 4; ++ks)
#pragma unroll
            for (int d = 0; d < 4; ++d) { const bf16x8 a = *(const LAS bf16x8*)(vp + d * 4096 + coff[ks]); o[d] = __builtin_amdgcn_mfma_f32_32x32x16_bf16(a, pf[ks], o[d], 0, 0, 0); }
    }
#undef AT_EXP
#undef AT_PACK
#undef AT_ISSUE
    asm volatile("s_waitcnt vmcnt(0) lgkmcnt(0)" ::: "memory");
    __builtin_amdgcn_s_barrier();
    asm volatile("" ::: "memory");
    l = xor32_sum(l);
    const float il = __builtin_amdgcn_rcpf(l);
    LAS float* xch = (LAS float*)(lds + wq * 16384) + lane;
    if (mp == 1) { const float lil = lam * il;
#pragma unroll
        for (int d = 0; d < 4; ++d)
#pragma unroll
            for (int r = 0; r < 16; ++r) xch[(d * 16 + r) * 64] = o[d][r] * lil; }
    __syncthreads();
    if (mp == 0) {
        float ss = 0.f;
#pragma unroll
        for (int d = 0; d < 4; ++d)
#pragma unroll
            for (int r = 0; r < 16; ++r) { const float a0 = o[d][r] * il - xch[(d * 16 + r) * 64]; o[d][r] = a0; ss += a0 * a0; }
        ss = xor32_sum(ss);
        const float rs = rsqrtf(ss * (1.f / 128.f) + 1e-5f) * one_m_li;
        const float* sw_ = P.in[11] + (size_t)li * 128;
        bf16_t* za = (bf16_t*)(P.ws + WS_ZA) + tok * 1024 + h * 128;
#pragma unroll
        for (int d = 0; d < 4; ++d)
#pragma unroll
            for (int q = 0; q < 4; ++q) { const int dd = d * 32 + 8 * q + 4 * hi; const f32x4 w4 = *(const f32x4*)(sw_ + dd); const u32x2 z = *(const u32x2*)(za + dd);
                const float y0 = o[d][4 * q] * rs * w4[0] * silu(bf_lo(z[0])), y1 = o[d][4 * q + 1] * rs * w4[1] * silu(bf_hi(z[0]));
                const float y2 = o[d][4 * q + 2] * rs * w4[2] * silu(bf_lo(z[1])), y3 = o[d][4 * q + 3] * rs * w4[3] * silu(bf_hi(z[1]));
                u32x2 w; w.x = cvt_pk_bf16(y0, y1); w.y = cvt_pk_bf16(y2, y3); *(u32x2*)(za + dd) = w; }
    }
}

constexpr int CTL_BAR = 1024;
#define XB_TMO      128
#define XB_XCNT(j)  (256  + 64 * (j))
#define XB_XSUB(j)  (1280 + 64 * (j))
#define XB_XGEN(j)  (2304 + 64 * (j))
#define XB_TOP      3328
#define XB_TOPGEN   3392
#define XCD_BAR_WORDS 3456
#define XB_SPIN_CAP (1u << 18)
__device__ __forceinline__ unsigned xb_ld(unsigned* p)              { return __hip_atomic_load(p, __ATOMIC_RELAXED, __HIP_MEMORY_SCOPE_AGENT); }
__device__ __forceinline__ unsigned xb_add(unsigned* p, unsigned v) { return __hip_atomic_fetch_add(p, v, __ATOMIC_RELAXED, __HIP_MEMORY_SCOPE_AGENT); }
__device__ __forceinline__ unsigned xb_xcc_id() { return (unsigned)__builtin_amdgcn_s_getreg((3 << 11) | 20) & 0xFu; }
#define XB_SPIN(cond, bar) do { unsigned _sp = 0; while (cond) { __builtin_amdgcn_s_sleep(1); \
    if ((++_sp & 255u) == 0u) { if (xb_ld(&(bar)[XB_TMO])) break; if (_sp > XB_SPIN_CAP) { atomicAdd(&(bar)[XB_TMO], 1u); break; } } } } while (0)
struct XcdBarrier { unsigned* bar; unsigned x; volatile LAS unsigned* st; };
__device__ __forceinline__ XcdBarrier xcd_barrier_post(unsigned* bar, volatile LAS unsigned* st) {
    XcdBarrier b; b.bar = bar; b.x = xb_xcc_id(); b.st = st;
    if (threadIdx.x == 0) (void)xb_add(&bar[XB_XCNT(b.x)], 1u);
    return b;
}
__device__ __forceinline__ void xcd_barrier_complete(unsigned* bar, unsigned x, unsigned& nloc, unsigned& nx) {
    const unsigned G = gridDim.x * gridDim.y * gridDim.z;
    unsigned sum, cnt, mine, sp = 0u;
    for (;;) {
        sum = 0u; cnt = 0u; mine = 0u;
#pragma unroll
        for (unsigned j = 0; j < 16; ++j) { const unsigned c = xb_ld(&bar[XB_XCNT(j)]); sum += c; cnt += (c > 0u) ? 1u : 0u; mine = (j == x) ? c : mine; }
        if (sum == G) break;
        __builtin_amdgcn_s_sleep(1);
        if ((++sp & 255u) == 0u) { if (xb_ld(&bar[XB_TMO])) break; if (sp > XB_SPIN_CAP) { atomicAdd(&bar[XB_TMO], 1u); break; } }
    }
    nloc = mine > 0u ? mine : 1u; nx = cnt > 0u ? cnt : 1u;
}
__device__ __forceinline__ void xcd_barrier(const XcdBarrier& b) {
    asm volatile("s_waitcnt vmcnt(0)" ::: "memory");
    __syncthreads();
    if (threadIdx.x == 0) {
        unsigned* bar = b.bar;
        __builtin_amdgcn_s_waitcnt(0);
        unsigned nloc = b.st[0], nx = b.st[1];
        if (nloc == 0u) { xcd_barrier_complete(bar, b.x, nloc, nx); b.st[0] = nloc; b.st[1] = nx; }
        const unsigned old = xb_add(&bar[XB_XSUB(b.x)], 1u);
        const unsigned gen = old / nloc;
        if (old + 1u == (gen + 1u) * nloc) {
            __builtin_amdgcn_fence(__ATOMIC_RELEASE, "agent");
            asm volatile("s_waitcnt vmcnt(0)" ::: "memory");
            const unsigned og = xb_add(&bar[XB_TOP], 1u);
            const unsigned tg = og / nx;
            if (og + 1u == (tg + 1u) * nx) xb_add(&bar[XB_TOPGEN], 1u);
            else XB_SPIN(xb_ld(&bar[XB_TOPGEN]) == tg, bar);
            __builtin_amdgcn_fence(__ATOMIC_ACQUIRE, "agent");
            xb_add(&bar[XB_XGEN(b.x)], 1u);
            asm volatile("s_waitcnt vmcnt(0)" ::: "memory");
        } else {
            XB_SPIN(xb_ld(&bar[XB_XGEN(b.x)]) == gen, bar);
            __builtin_amdgcn_fence(__ATOMIC_ACQUIRE, "agent");
            asm volatile("s_waitcnt vmcnt(0)" ::: "memory");
        }
    }
    __syncthreads();
}
#ifndef PHMASK
#define PHMASK 0xFFFF
#endif
#define PH(k) ((PHMASK >> (k)) & 1)
#ifndef DBG_NO_ATT
#define DBG_NO_ATT 0
#endif
#ifndef DBG_NO_SSM
#define DBG_NO_SSM 0
#endif
__global__ void __launch_bounds__(512, 2) trunk_fwd(Params P) {
    extern __shared__ __attribute__((aligned(16))) unsigned char lds_raw[];
    LAS unsigned char* lds = (LAS unsigned char*)lds_raw;
    cg::grid_group grid = cg::this_grid();
    int tid = threadIdx.x, lane = tid & 63, wid = __builtin_amdgcn_readfirstlane(tid >> 6);
    int G = gridDim.x, bx = blockIdx.x;
    int vcu = (G % 8 == 0) ? (bx % 8) * (G / 8) + bx / 8 : bx;
    int gw = vcu * 8 + wid; const int NGW = G * 8;
    Params Q = P;
    unsigned char* ws = Q.ws;
    bf16_t* XB = (bf16_t*)(ws + WS_XB);
#define LAUNDER() do { tid = threadIdx.x; asm volatile("" : "+v"(tid)); lane = tid & 63; wid = __builtin_amdgcn_readfirstlane(tid >> 6); bx = blockIdx.x; asm volatile("" : "+s"(bx)); \
        vcu = (G % 8 == 0) ? (bx % 8) * (G / 8) + bx / 8 : bx; gw = vcu * 8 + wid; ws = P.ws; asm volatile("" : "+s"(ws)); Q.ws = ws; XB = (bf16_t*)(ws + WS_XB); } while (0)

#define GSYNC() xcd_barrier(xbar)
    if (bx == 0) for (int z = tid; z < CTL_BAR + XCD_BAR_WORDS; z += 512) ((unsigned*)ws)[z] = 0u;
    volatile LAS unsigned* xst = (volatile LAS unsigned*)(lds + LDS_BYTES - 64);
    if (tid < 2) xst[tid] = 0u;
    __syncthreads();
    for (int it = bx; it < NG * 4; it += G) ssm_tables(Q, 0, lds, it);
    __syncthreads();
    if (PH(0)) convert_weights(Q, 0, lds, gw, NGW, lane, wid);
    { const float* x = P.in[0]; const size_t n8 = (size_t)T * DM / 8, gt = (size_t)gw * 64 + lane, NT_ = (size_t)NGW * 64;
#pragma unroll 4
      for (size_t i = gt; i < n8; i += NT_) { const f32x4 a = *(const f32x4*)(x + i * 8), b = *(const f32x4*)(x + i * 8 + 4);
          u32x4 w; w.x = cvtpk(a[0], a[1]); w.y = cvtpk(a[2], a[3]); w.z = cvtpk(b[0], b[1]); w.w = cvtpk(b[2], b[3]); *(u32x4*)(XB + i * 8) = w;
          *(u32x2*)(ws + WS_XB8 + i * 8) = (u32x2){cvt4_fp8(a[0], a[1], a[2], a[3]), cvt4_fp8(b[0], b[1], b[2], b[3])}; } }
    grid.sync();
    const XcdBarrier xbar = xcd_barrier_post((unsigned*)P.ws + CTL_BAR, xst);

#pragma unroll 1
    for (int li = 0; li < DEPTH; ++li) {
        const float lambda_init = (li == 0) ? 0.2f : 0.35550906759096783f;
        LAUNDER();
        {
            pg8::Gemm g{(const bf16_t*)(ws + WS_XB8), (const bf16_t*)(ws + WS_WIN), T, NCOLS, DM / 2, 2}; pg8::StaticOrder S; S.init(T, NCOLS, G, bx, FP8_TILES);
            Epi<EPI_INPROJ> E{}; E.ws = ws; E.sc_all = 1.0f / 64.0f;
            pg8::gemm_phase<Epi<EPI_INPROJ>, pg8::StaticOrder, true>(lds, g, S, E); }
        if (PH(1)) {   pg8::Gemm g{XB, (const bf16_t*)(ws + WS_WIN), T, NCOLS, DM}; pg8::StaticOrder S; S.init(T, NCOLS, G, bx, BF16_TILES);
            Epi<EPI_INPROJ> E{}; E.ws = ws; E.sc_all = 1.0f;
            pg8::gemm_phase(lds, g, S, E); }
        GSYNC();
        LAUNDER();
        if (PH(2)) {   pg8::Gemm g{(const bf16_t*)(ws + WS_WIN) + (size_t)2048 * DM, XB, AW, T, DM}; pg8::StaticOrder S; S.init(AW, T, G, bx);
            Epi<EPI_PLAIN> E{}; E.O = (bf16_t*)(ws + WS_VT); E.ldc = T;
            pg8::gemm_phase(lds, g, S, E); }
#if !DBG_NO_SSM
        LAUNDER();
        if (PH(4)) for (int it = gw; it < NG * 16 * 4; it += NGW) ssm_local(Q, it, lane);
#endif
        GSYNC();
#if !DBG_NO_SSM
        LAUNDER();
        if (PH(5)) { const int nb = (G >= 128) ? 128 : G;
            if (bx < nb) for (int wv_ = bx + nb * wid; wv_ < 128; wv_ += nb * 8) ssm_scan(Q, wv_ * 64 + lane); }
        for (int it = gw; it < NCH * 16; it += NGW) kmax_task(Q, it, lane);
        GSYNC();
#endif
        LAUNDER();
#if !DBG_NO_SSM
        if (PH(6)) for (int u4 = vcu * 4; u4 < NG * 16; u4 += G * 4)
            for (int k = 0; k < 4; ++k) ssm_y_unit(Q, li, lds, u4 + k, k == 0);
#endif
#if !DBG_NO_ATT
        if (PH(7)) {   float lam;
            { const float a = P.in[7][li * 64 + lane] * P.in[8][li * 64 + lane], b2 = P.in[9][li * 64 + lane] * P.in[10][li * 64 + lane];
              lam = expf(wave_sum(a, lane)) - expf(wave_sum(b2, lane)) + lambda_init; }
            LAS unsigned* qslot = (LAS unsigned*)(lds + AT_CTL) + 1;
            for (;;) {
                __syncthreads();
                if (tid == 0) *qslot = atomicAdd((unsigned*)ws + CTL_QCTR, 1u);
                __syncthreads();
                const unsigned u = *qslot;
                if (u >= 2048u) break;
                const int bhr = (int)(u >> 7), qb = 127 - (int)(u & 127);
                attn_unit(Q, li, lds, bhr & 1, 7 - (bhr >> 1), qb, lam, 1.0f - lambda_init);
            }
        }
#endif
        GSYNC();
        LAUNDER();
#if !DBG_NO_SSM
        if (PH(8)) {   pg8::Gemm g{(const bf16_t*)(ws + WS_YG8), (const bf16_t*)(ws + WS_WGLU), T, AW, AW / 2}; pg8::StaticOrder S; S.init(T, AW, G, bx);
            Epi<EPI_GLU> E{}; E.O = (bf16_t*)(ws + WS_ZS); E.ldc = AW; E.X1 = (const bf16_t*)(ws + WS_YG); E.sc_all = 1.0f / 64.0f;
            pg8::gemm_phase<Epi<EPI_GLU>, pg8::StaticOrder, true>(lds, g, S, E); }
        GSYNC();
#endif
        LAUNDER();
        if (PH(9)) {   pg8::Gemm g{(const bf16_t*)(ws + WS_ZA), (const bf16_t*)(ws + WS_WAO), T, DM, AW}; pg8::StaticOrder S; S.init(T, DM, G, bx);
            Epi<EPI_MRG_A> E{}; E.O = (bf16_t*)(ws + WS_GA); E.ldc = DM;
            pg8::gemm_phase(lds, g, S, E); }
        if (PH(10)) {   pg8::Gemm g{(const bf16_t*)(ws + WS_ZS), (const bf16_t*)(ws + WS_WSO), T, DM, AW}; pg8::StaticOrder S; S.init(T, DM, G, bx);
            Epi<EPI_MRG_B> E{}; E.O = (bf16_t*)(ws + WS_GA); E.ldc = DM; E.X1 = (const bf16_t*)(ws + WS_GS);
            pg8::gemm_phase(lds, g, S, E); }
        GSYNC();
        LAUNDER();
        if (PH(12)) {   pg8::Gemm g{(const bf16_t*)(ws + WS_PB), (const bf16_t*)(ws + WS_WPLE), T, DM, PLE}; pg8::StaticOrder S; S.init(T, DM, G, bx);
            Epi<EPI_MRG_A> E{}; E.O = (bf16_t*)(ws + WS_GP); E.ldc = DM;
            pg8::gemm_phase(lds, g, S, E); }
        const bool ln_fused = (G == 256);
        if (ln_fused) {   pg8::Gemm g{(const bf16_t*)(ws + WS_GA), (const bf16_t*)(ws + WS_WOUT), T, DM, DM}; pg8::StaticOrder S; S.init(T, DM, G, bx); S.wgm = 4;
            EpiOutLn E{}; E.res = (li == 0) ? P.in[0] : P.out; E.out = P.out; E.ple = (const bf16_t*)(ws + WS_GP); E.g = P.in[21] + (size_t)li * DM; E.b = P.in[22] + (size_t)li * DM;
            E.xb = (li + 1 < DEPTH) ? XB : nullptr; E.xb8 = ws + WS_XB8; E.stats = (unsigned long long*)(ws + WS_LNSTAT); E.cnt = (unsigned*)ws + CTL_LNCNT + li * 128;
            pg8::gemm_phase(lds, g, S, E); }
        else if (PH(11)) {   pg8::Gemm g{(const bf16_t*)(ws + WS_GA), (const bf16_t*)(ws + WS_WOUT), T, DM, DM}; pg8::StaticOrder S; S.init(T, DM, G, bx);
            Epi<EPI_OUT_A> E{}; E.res = (li == 0) ? P.in[0] : P.out; E.out = P.out; E.ldc = DM; E.X1 = (const bf16_t*)(ws + WS_GP);
            pg8::gemm_phase(lds, g, S, E); }
        if (li + 1 < DEPTH) { __syncthreads(); convert_weights(Q, li + 1, lds, gw, NGW, lane, wid, 1); }
        if (!ln_fused || li + 1 < DEPTH) GSYNC();
        LAUNDER();
        if (!ln_fused && PH(13)) ln_rows(P.out, P.in[21] + (size_t)li * DM, P.in[22] + (size_t)li * DM, (li + 1 < DEPTH) ? XB : nullptr, ws + WS_XB8, gw, NGW, lane);
        if (li + 1 < DEPTH) { __syncthreads(); if (bx == 0 && tid < 80) ((unsigned*)ws)[tid] = 0u; for (int it = bx; it < NG * 4; it += G) ssm_tables(Q, li + 1, lds, it);
            __syncthreads(); if (PH(0)) convert_weights(Q, li + 1, lds, gw, NGW, lane, wid, 2); GSYNC(); }
    }
}

extern "C" void kernel_launch(void* const* d_in, const int* in_sizes, int n_in, void* d_out, int out_size, void* d_ws, size_t ws_size, hipStream_t stream) {
    static int grid = 0;
    if (grid == 0) {
        if (n_in != 23 || ws_size < WS_END) { fprintf(stderr, "kernel_launch: unexpected n_in %d / ws %zu\n", n_in, ws_size); grid = -1; return; }
        int dev = 0, cus = 0, per_cu = 0;
        hipGetDevice(&dev); hipDeviceGetAttribute(&cus, hipDeviceAttributeMultiprocessorCount, dev);
        if (hipFuncSetAttribute((const void*)trunk_fwd, hipFuncAttributeMaxDynamicSharedMemorySize, LDS_BYTES) != hipSuccess) { fprintf(stderr, "hipFuncSetAttribute failed\n"); grid = -1; return; }
        hipOccupancyMaxActiveBlocksPerMultiprocessor(&per_cu, (const void*)trunk_fwd, 512, LDS_BYTES);
        if (per_cu < 1) { fprintf(stderr, "occupancy query says %d\n", per_cu); per_cu = 1; }
        (void)hipGetLastError();
        grid = cus;
    }
    if (grid < 0) return;
    Params p{};
    for (int i = 0; i < 23; ++i) p.in[i] = (const float*)d_in[i];
    p.out = (float*)d_out; p.ws = (unsigned char*)d_ws;
    void* args[] = {&p};
    hipError_t e = hipLaunchCooperativeKernel((const void*)trunk_fwd, dim3(grid), dim3(512), args, LDS_BYTES, stream);
    if (e != hipSuccess) fprintf(stderr, "cooperative launch failed: %s (grid %d)\n", hipGetErrorString(e), grid);
}
```

```cpp
#include <hip/hip_runtime.h>
#include <hip/hip_cooperative_groups.h>
#include <cstdio>
#include <cstdint>
namespace cg = cooperative_groups;

#define LAS __attribute__((address_space(3)))
typedef unsigned short bf16_t;
typedef short bf16x8 __attribute__((ext_vector_type(8)));
typedef short s16x4 __attribute__((ext_vector_type(4)));
typedef float f32x4 __attribute__((ext_vector_type(4)));
typedef float f32x2 __attribute__((ext_vector_type(2)));
typedef float f32x16 __attribute__((ext_vector_type(16)));
typedef unsigned u32x4 __attribute__((ext_vector_type(4)));
typedef unsigned u32x2 __attribute__((ext_vector_type(2)));

constexpr int BATCH = 2, SEQ = 16384, DM = 2048, T = BATCH * SEQ, DEPTH = 2;
constexpr int NCOLS = 12288, PLE = 256, AW = 1024, NH = 8;
constexpr int NG = 64, NCH = T / 64;
constexpr float LOG2E = 1.4426950408889634f;
constexpr float QSCALE = 0.125f * LOG2E;
constexpr float ALPHA_RES = 1.4142135623730951f;

constexpr size_t MiB = 1u << 20;
constexpr size_t WS_WIN = 1 * MiB, WS_WAO = 49 * MiB, WS_WSO = 53 * MiB, WS_WOUT = 57 * MiB, WS_WPLE = 65 * MiB, WS_WGLU = 66 * MiB;
constexpr size_t WS_PB = 68 * MiB;
constexpr size_t WS_XLOC = WS_WIN + 16 * MiB;
constexpr size_t WS_Q = 84 * MiB, WS_K = 148 * MiB, WS_VT = 212 * MiB, WS_ZA = 276 * MiB, WS_U = 340 * MiB, WS_ZS = 404 * MiB;
constexpr size_t WS_GA = 468 * MiB, WS_GS = 596 * MiB, WS_GP = 724 * MiB;
constexpr size_t WS_XB = 852 * MiB;
constexpr size_t WS_YG = 852 * MiB, WS_XS = 932 * MiB, WS_YG8 = 940 * MiB;
constexpr size_t WS_KTAB = 980 * MiB, WS_ETAB = 983 * MiB, WS_FTAB = 999 * MiB, WS_A64 = 1015 * MiB;
constexpr unsigned long long FP8_TILES = (0xFull << 12) | (0xFFFFFull << 20), BF16_TILES = 0xFFull | (0xFull << 16) | (0xFFull << 40);
constexpr size_t WS_XB8 = WS_VT;
constexpr size_t WS_END = 1018 * MiB;

constexpr int LDS_BYTES = 147456;

__device__ __forceinline__ unsigned cvt_pk_bf16(float lo, float hi) { unsigned r; asm volatile("v_cvt_pk_bf16_f32 %0, %1, %2" : "=v"(r) : "v"(lo), "v"(hi)); return r; }
typedef __bf16 bf16x2_t __attribute__((ext_vector_type(2)));
__device__ __forceinline__ unsigned cvtpk(float lo, float hi) { f32x2 v = {lo, hi}; bf16x2_t b = __builtin_convertvector(v, bf16x2_t); return __builtin_bit_cast(unsigned, b); }
__device__ __forceinline__ unsigned cvt4_fp8(float a, float b, float c, float d) { int v = 0; v = __builtin_amdgcn_cvt_pk_fp8_f32(a, b, v, false); v = __builtin_amdgcn_cvt_pk_fp8_f32(c, d, v, true); return (unsigned)v; }
__device__ __forceinline__ float bf_lo(unsigned w) { return __uint_as_float(w << 16); }
__device__ __forceinline__ float bf_hi(unsigned w) { return __uint_as_float(w & 0xffff0000u); }
__device__ __forceinline__ float bf1(bf16_t v) { return __uint_as_float(((unsigned)v) << 16); }
__device__ __forceinline__ float ex2(float x) { return __builtin_amdgcn_exp2f(x); }
__device__ __forceinline__ float sigm(float x) { return __builtin_amdgcn_rcpf(1.0f + ex2(-x * LOG2E)); }
__device__ __forceinline__ float silu(float x) { return x * sigm(x); }
__device__ __forceinline__ float gelu_tanh(float y) { const float z = 1.5957691216057308f * (y + 0.044715f * y * y * y); return y * sigm(z); }
__device__ __forceinline__ unsigned* lds_generic_ptr(LAS unsigned* p) { return (unsigned*)p; }
__device__ __forceinline__ float fadd_s(float a, float b) { float r; asm("v_add_f32_e32 %0, %1, %2" : "=v"(r) : "v"(a), "v"(b)); return r; }
__device__ __forceinline__ float fma2_s(float a, float c) { float r; asm("v_fma_f32 %0, %1, 2.0, %2" : "=v"(r) : "v"(a), "v"(c)); return r; }
__device__ __forceinline__ float max3f(float a, float b, float c) { float r; asm("v_max3_f32 %0, %1, %2, %3" : "=v"(r) : "v"(a), "v"(b), "v"(c)); return r; }
__device__ __forceinline__ int crow(int r, int hi) { return (r & 3) + 8 * (r >> 2) + 4 * hi; }

namespace pg8 {
constexpr int BM = 256, BK = 64, HALF = 128, HTB = HALF * BK * 2, STAGE_BYTES = 8 * HTB, NXCD = 8, WGM = 8;
__host__ __device__ __forceinline__ int lds_byte(int r, int c) { const int st = (r >> 4) * 2 + (c >> 5), rr = r & 15, cc = c & 31, ob = rr * 64 + cc * 2; return st * 1024 + (ob ^ (((ob >> 9) & 1) << 5)); }
__host__ __device__ __forceinline__ void stage_rc(int b, int& R, int& C) { const int st = b / 1024, sb = b % 1024, swz = sb ^ (((sb >> 9) & 1) << 5); R = (st >> 1) * 16 + swz / 64; C = (st & 1) * 32 + (swz % 64) / 2; }
__host__ __device__ __forceinline__ int perm32(int rho) { const int n = rho >> 4, i = rho & 15; return 8 * (i >> 2) + 4 * n + (i & 3); }

struct Unit { int pm, pn; };
struct Gemm { const bf16_t* A; const bf16_t* Bt; int M, N, K; int bmul = 1; };

struct StaticOrder {
    int nM, nN, nwg, G, c, wgm = WGM; unsigned long long mask;
    __device__ void init(int M, int N, int G_, int c_, unsigned long long mask_ = 0ull) { nM = M / BM; nN = mask_ ? __builtin_popcountll(mask_) : N / BM; nwg = nM * nN; G = G_; c = c_; mask = mask_; }
    __device__ bool next(int i, Unit& u) const {
        const long L = (long)i * G + c; if (L >= nwg) return false;
        int wgid = (int)L; { const int q = nwg / NXCD, r = nwg % NXCD, xcd = wgid % NXCD, off = wgid / NXCD; wgid = (xcd < r ? xcd * (q + 1) : r * (q + 1) + (xcd - r) * q) + off; }
        const int nig = wgm * nN, gid = wgid / nig, fm = gid * wgm, gsz = (nM - fm) < wgm ? (nM - fm) : wgm;
        u.pm = fm + ((wgid % nig) % gsz); u.pn = (wgid % nig) / gsz; if (mask) { unsigned long long mm = mask; for (int k = 0; k < u.pn; ++k) mm &= mm - 1; u.pn = __builtin_ctzll(mm); } return true;
    }
};

typedef int i32x8 __attribute__((ext_vector_type(8)));
typedef int i32x4 __attribute__((ext_vector_type(4)));
template <class Epi, class Sched, bool FP8 = false>
__device__ __forceinline__ void gemm_phase(LAS unsigned char* lds, const Gemm g, const Sched& S, const Epi& E) {
    int tid = threadIdx.x; asm volatile("" : "+v"(tid));
    const int wid = __builtin_amdgcn_readfirstlane(tid >> 6), lane = tid & 63, wr = wid >> 2, wc = wid & 3, fr = lane & 15, fq = lane >> 4;
    const int K = g.K, nt = K / BK;
    unsigned voffA[2], voffB[2];
#pragma unroll
    for (int i = 0; i < 2; ++i) { int R, C; stage_rc(tid * 16 + i * 8192, R, C); const int Rb = Epi::PERM ? ((R & ~31) + perm32(R & 31)) : R;
        voffA[i] = (unsigned)(R * K + C) * 2u; voffB[i] = (unsigned)(Rb * K + C) * 2u; }
    const size_t kstep = (size_t)(BK * 2);
    const size_t hstep = (size_t)HALF * K * 2;
    const size_t tstep = 2 * hstep;
    const unsigned ldsw = (unsigned)wid * 1024u;
    const int aoff = lds_byte(wr * 64 + fr, fq * 8), boff = lds_byte(wc * 32 + fr, fq * 8);
#define PG8_SA(b, h) (((b) * 2 + (h)) * HTB)
#define PG8_SB(b, h) ((4 + (b) * 2 + (h)) * HTB)
#define PG8_STAGE(bufoff, gbase, voff) do { _Pragma("unroll") for (int _i = 0; _i < 2; ++_i) \
        __builtin_amdgcn_global_load_lds((const unsigned*)((const char*)(gbase) + (voff)[_i]), (LAS unsigned*)(lds + (bufoff) + ldsw + _i * 8192), 16, 0, 0); } while (0)
#define PG8_LDA(dst, b, h) do { _Pragma("unroll") for (int m = 0; m < 4; ++m) _Pragma("unroll") for (int k = 0; k < 2; ++k) dst[m][k] = *(const LAS bf16x8*)(lds + PG8_SA(b, h) + aoff + m * 2048 + k * 1024); } while (0)
#define PG8_LDB(dst, b, h) do { _Pragma("unroll") for (int n = 0; n < 2; ++n) _Pragma("unroll") for (int k = 0; k < 2; ++k) dst[n][k] = *(const LAS bf16x8*)(lds + PG8_SB(b, h) + boff + n * 2048 + k * 1024); } while (0)
#define PG8_CAT(x) __builtin_shufflevector(__builtin_bit_cast(i32x4, (x)[0]), __builtin_bit_cast(i32x4, (x)[1]), 0, 1, 2, 3, 4, 5, 6, 7)
#define PG8_MMA(ai, bj, At, Bt) do { __builtin_amdgcn_s_setprio(1); _Pragma("unroll") for (int m = 0; m < 4; ++m) _Pragma("unroll") for (int n = 0; n < 2; ++n) { \
        if constexpr (FP8) { const i32x8 b8_ = PG8_CAT(Bt[n]), a8_ = PG8_CAT(At[m]);   \
            asm volatile("v_mfma_scale_f32_16x16x128_f8f6f4 %0, %1, %2, %0, %3, %3 op_sel_hi:[0,0,0]" : "+v"(acc[ai][bj][m][n]) : "v"(b8_), "v"(a8_), "v"(one_scale)); } \
        else { _Pragma("unroll") for (int k = 0; k < 2; ++k) acc[ai][bj][m][n] = __builtin_amdgcn_mfma_f32_16x16x32_bf16(Bt[n][k], At[m][k], acc[ai][bj][m][n], 0, 0, 0); } } \
        __builtin_amdgcn_s_setprio(0); } while (0)
#define PG8_WAIT_V(n) asm volatile("s_waitcnt vmcnt(" #n ")" ::: "memory")
#define PG8_WAIT_L(n) asm volatile("s_waitcnt lgkmcnt(" #n ")" ::: "memory")
#define PG8_BAR __builtin_amdgcn_s_barrier()
#define PG8_SCHED __builtin_amdgcn_sched_barrier(0)
    const int one_scale = 0x7f7f7f7f;
    Unit cur, nxt; int ui = 0;
    if (!S.next(0, cur)) return;
    f32x4 acc[2][2][4][2];
#pragma unroll
    for (int a = 0; a < 2; ++a)
#pragma unroll
        for (int b = 0; b < 2; ++b)
#pragma unroll
            for (int m = 0; m < 4; ++m)
#pragma unroll
                for (int n = 0; n < 2; ++n) acc[a][b][m][n] = (f32x4){0.f, 0.f, 0.f, 0.f};
    bf16x8 At[4][2], B0[2][2], B1[2][2];
    const char* cA = (const char*)g.A + (size_t)cur.pm * tstep; const char* cB = (const char*)g.Bt + (size_t)cur.pn * tstep * g.bmul;
    PG8_STAGE(PG8_SB(0, 0), cB, voffB); PG8_STAGE(PG8_SB(0, 1), cB + hstep, voffB); PG8_STAGE(PG8_SA(0, 0), cA, voffA); PG8_STAGE(PG8_SA(0, 1), cA + hstep, voffA);
    if (wr == 1) PG8_BAR;
    PG8_WAIT_V(2); PG8_BAR;
    PG8_STAGE(PG8_SB(1, 0), cB + kstep, voffB); PG8_STAGE(PG8_SA(1, 0), cA + kstep, voffA); PG8_STAGE(PG8_SB(1, 1), cB + hstep + kstep, voffB);
    PG8_WAIT_V(6); PG8_BAR;
    for (;;) {
        const bool has_next = S.next(ui + 1, nxt);
        const char* nA = has_next ? (const char*)g.A + (size_t)nxt.pm * tstep : cA; const char* nB = has_next ? (const char*)g.Bt + (size_t)nxt.pn * tstep * g.bmul : cB;
        for (int t = 0; t < nt; t += 2) {
            const bool last = (t == nt - 2);
            const char* a1 = cA + (size_t)(t + 1) * kstep;
            const char* a2 = last ? nA : cA + (size_t)(t + 2) * kstep; const char* b2 = last ? nB : cB + (size_t)(t + 2) * kstep;
            const char* a3 = a2 + kstep; const char* b3 = b2 + kstep;
            PG8_LDB(B0, 0, 0); PG8_LDB(B1, 0, 1); PG8_SCHED; PG8_LDA(At, 0, 0); PG8_STAGE(PG8_SA(1, 1), a1 + hstep, voffA);
            PG8_WAIT_V(8); PG8_WAIT_L(0); PG8_BAR; PG8_MMA(0, 0, At, B0); PG8_MMA(0, 1, At, B1); PG8_BAR; PG8_SCHED;
            PG8_LDA(At, 0, 1); PG8_STAGE(PG8_SB(0, 0), b2, voffB); PG8_STAGE(PG8_SB(0, 1), b2 + hstep, voffB); PG8_STAGE(PG8_SA(0, 0), a2, voffA);
            PG8_WAIT_V(8); PG8_WAIT_L(0); PG8_BAR; PG8_MMA(1, 0, At, B0); PG8_MMA(1, 1, At, B1); PG8_BAR; PG8_SCHED;
            PG8_LDB(B0, 1, 0); PG8_LDB(B1, 1, 1); PG8_SCHED; PG8_LDA(At, 1, 0); PG8_STAGE(PG8_SA(0, 1), a2 + hstep, voffA);
            PG8_WAIT_V(8); PG8_WAIT_L(0); PG8_BAR; PG8_MMA(0, 0, At, B0); PG8_MMA(0, 1, At, B1); PG8_BAR; PG8_SCHED;
            PG8_LDA(At, 1, 1); PG8_STAGE(PG8_SB(1, 0), b3, voffB); PG8_STAGE(PG8_SB(1, 1), b3 + hstep, voffB); PG8_STAGE(PG8_SA(1, 0), a3, voffA);
            PG8_WAIT_V(8); PG8_WAIT_L(0); PG8_BAR; PG8_MMA(1, 0, At, B0); PG8_MMA(1, 1, At, B1); PG8_BAR; PG8_SCHED;
        }
        if (wr == 0) PG8_BAR;
        if constexpr (FP8) asm volatile("s_nop 15\n\ts_nop 15" ::: "memory");
        if constexpr (Epi::FUSED) E.fused(acc, cur, wr, wc, lds); else E(acc, cur, wr, wc, fr, fq);
        if (!has_next) break;
#pragma unroll
        for (int a = 0; a < 2; ++a)
#pragma unroll
            for (int b = 0; b < 2; ++b)
#pragma unroll
                for (int m = 0; m < 4; ++m)
#pragma unroll
                    for (int n = 0; n < 2; ++n) acc[a][b][m][n] = (f32x4){0.f, 0.f, 0.f, 0.f};
        cur = nxt; cA = nA; cB = nB; ++ui;
        if (wr == 1) PG8_BAR;
    }
    PG8_WAIT_V(0);
    PG8_BAR;
#undef PG8_SA
#undef PG8_SB
#undef PG8_STAGE
#undef PG8_LDA
#undef PG8_LDB
#undef PG8_MMA
#undef PG8_CAT
#undef PG8_WAIT_V
#undef PG8_WAIT_L
#undef PG8_BAR
#undef PG8_SCHED
}
}

enum { EPI_INPROJ = 0, EPI_PLAIN = 1  , EPI_GLU = 2, EPI_MRG_A = 3, EPI_MRG_B = 4, EPI_OUT_A = 5, EPI_OUT_B = 6 };
template <int MODE> struct Epi {
    static constexpr bool PERM = (MODE <= EPI_OUT_A), FUSED = false;
    unsigned char* ws;
    float sc_all;
    bf16_t* O; int ldc;
    const bf16_t* X1;
    const float* res; float* out;
    __device__ __forceinline__ void operator()(const f32x4 (&acc)[2][2][4][2], const pg8::Unit& u, int wr, int wc, int fr_, int fq_) const {
        int t2 = threadIdx.x; asm volatile("" : "+v"(t2)); const int fr = t2 & 15, fq = (t2 >> 4) & 3;
        if constexpr (PERM) {
            bf16_t* base = O; int ld = ldc; int colt = u.pn * 256; float sc = 1.f;
            if constexpr (MODE == EPI_INPROJ) {
                if (u.pn < 24) { base = (bf16_t*)(ws + WS_Q + (size_t)(u.pn >> 2) * (64 * MiB)); ld = 1024; colt = (u.pn & 3) * 256; if (u.pn < 4) sc = QSCALE; }
                else { const int q = u.pn - 24; base = (bf16_t*)(ws + WS_GA + (size_t)(q >> 3) * (128 * MiB)); ld = 2048; colt = (q & 7) * 256; }
                sc *= sc_all;
            }
            const int row0 = u.pm * 256 + wr * 64 + fr, col0 = colt + wc * 32 + 8 * fq;
#pragma unroll
            for (int ai = 0; ai < 2; ++ai)
#pragma unroll
                for (int m = 0; m < 4; ++m) { const size_t roff = (size_t)(row0 + ai * 128 + m * 16) * ld + col0;
#pragma unroll
                    for (int bj = 0; bj < 2; ++bj) { f32x4 v0 = acc[ai][bj][m][0], v1 = acc[ai][bj][m][1]; const size_t off = roff + bj * 128;
                        float v[8] = {v0[0], v0[1], v0[2], v0[3], v1[0], v1[1], v1[2], v1[3]};
                        if constexpr (MODE == EPI_INPROJ) {
#pragma unroll
                            for (int i = 0; i < 8; ++i) v[i] *= sc;
                        }
                        if constexpr (MODE == EPI_GLU) {
                            const u32x4 yg = *(const u32x4*)(X1 + off); const u32x4 zs = *(const u32x4*)(base + off);
#pragma unroll
                            for (int i = 0; i < 4; ++i) { v[2 * i] = bf_lo(yg[i]) * sigm(v[2 * i] * sc_all) * silu(bf_lo(zs[i])); v[2 * i + 1] = bf_hi(yg[i]) * sigm(v[2 * i + 1] * sc_all) * silu(bf_hi(zs[i])); }
                        }
                        if constexpr (MODE == EPI_MRG_A) {
                            const u32x4 ga = *(const u32x4*)(base + off);
#pragma unroll
                            for (int i = 0; i < 4; ++i) { v[2 * i] *= sigm(bf_lo(ga[i])); v[2 * i + 1] *= sigm(bf_hi(ga[i])); }
                        }
                        if constexpr (MODE == EPI_MRG_B) {
                            const u32x4 ga = *(const u32x4*)(base + off); const u32x4 gs = *(const u32x4*)(X1 + off);
#pragma unroll
                            for (int i = 0; i < 4; ++i) { v[2 * i] = bf_lo(ga[i]) + sigm(bf_lo(gs[i])) * v[2 * i]; v[2 * i + 1] = bf_hi(ga[i]) + sigm(bf_hi(gs[i])) * v[2 * i + 1]; }
                        }
                        if constexpr (MODE == EPI_OUT_A) {
                            const f32x4 r0 = *(const f32x4*)(res + off), r1 = *(const f32x4*)(res + off + 4); const u32x4 pl = *(const u32x4*)(X1 + off);
                            f32x4 o0, o1;
                            o0[0] = r0[0] * ALPHA_RES + v[0] + bf_lo(pl[0]); o0[1] = r0[1] * ALPHA_RES + v[1] + bf_hi(pl[0]); o0[2] = r0[2] * ALPHA_RES + v[2] + bf_lo(pl[1]); o0[3] = r0[3] * ALPHA_RES + v[3] + bf_hi(pl[1]);
                            o1[0] = r1[0] * ALPHA_RES + v[4] + bf_lo(pl[2]); o1[1] = r1[1] * ALPHA_RES + v[5] + bf_hi(pl[2]); o1[2] = r1[2] * ALPHA_RES + v[6] + bf_lo(pl[3]); o1[3] = r1[3] * ALPHA_RES + v[7] + bf_hi(pl[3]);
                            *(f32x4*)(out + off) = o0; *(f32x4*)(out + off + 4) = o1;
                            continue;
                        }
                        u32x4 w; w.x = cvt_pk_bf16(v[0], v[1]); w.y = cvt_pk_bf16(v[2], v[3]); w.z = cvt_pk_bf16(v[4], v[5]); w.w = cvt_pk_bf16(v[6], v[7]);
                        if constexpr (MODE == EPI_PLAIN) { const size_t o2 = (off & ~(size_t)15) + 4 * (fq & 1); *(u32x2*)(base + o2) = (u32x2){w.x, w.y}; *(u32x2*)(base + o2 + 8) = (u32x2){w.z, w.w}; }
                        else *(u32x4*)(base + off) = w; } }
        } else {
            const int row0 = u.pm * 256 + wr * 64 + fr, col0 = u.pn * 256 + wc * 32 + 4 * fq;
#pragma unroll
            for (int ai = 0; ai < 2; ++ai)
#pragma unroll
                for (int m = 0; m < 4; ++m) { const size_t roff = (size_t)(row0 + ai * 128 + m * 16) * DM + col0;
#pragma unroll
                    for (int bj = 0; bj < 2; ++bj)
#pragma unroll
                        for (int n = 0; n < 2; ++n) { const size_t off = roff + bj * 128 + n * 16; f32x4 a = acc[ai][bj][m][n];
                            if constexpr (MODE == EPI_OUT_A) { const f32x4 r = *(const f32x4*)(res + off); *(f32x4*)(out + off) = r * ALPHA_RES + a; }
                            else { const u32x2 gp = *(const u32x2*)(X1 + off); f32x4 o = *(const f32x4*)(out + off);
                                o[0] += sigm(bf_lo(gp[0])) * a[0]; o[1] += sigm(bf_hi(gp[0])) * a[1]; o[2] += sigm(bf_lo(gp[1])) * a[2]; o[3] += sigm(bf_hi(gp[1])) * a[3];
                                *(f32x4*)(out + off) = o; } }
                    asm volatile("" ::: "memory"); }
        }
    }
};


__device__ __forceinline__ void transpose_item(const float* W, int K, int N, bf16_t* WT, LAS float* scr, int item, int lane) {
    const int nblk = N / 32, kb = item / nblk, nb = item % nblk, k0 = 64 * kb, n0 = 32 * nb;
    float wv[32];
#pragma unroll
    for (int i = 0; i < 32; ++i) wv[i] = W[(size_t)(k0 + 2 * i + (lane >> 5)) * N + n0 + (lane & 31)];
#pragma unroll
    for (int i = 0; i < 32; ++i) scr[(2 * i + (lane >> 5)) * 33 + (lane & 31)] = wv[i];
    asm volatile("s_waitcnt lgkmcnt(0)" ::: "memory");
    const int c = lane & 7;
#pragma unroll
    for (int j = 0; j < 4; ++j) { const int n = (lane >> 3) + 8 * j; const LAS float* s = scr + (8 * c) * 33 + n;
        u32x4 o; o.x = cvt_pk_bf16(s[0 * 33], s[1 * 33]); o.y = cvt_pk_bf16(s[2 * 33], s[3 * 33]); o.z = cvt_pk_bf16(s[4 * 33], s[5 * 33]); o.w = cvt_pk_bf16(s[6 * 33], s[7 * 33]);
        *(u32x4*)(WT + (size_t)(n0 + n) * K + k0 + 8 * c) = o; }
    asm volatile("s_waitcnt lgkmcnt(0)" ::: "memory");
}

__device__ __forceinline__ void transpose_item_fp8(const float* W, int K, int N, int ncol0, int nblk, unsigned char* WT8, LAS float* scr, int item, int lane) {
    const int kb = item / nblk, nb = item % nblk, k0 = 64 * kb, n0 = 32 * nb;
    float wv[32];
#pragma unroll
    for (int i = 0; i < 32; ++i) wv[i] = W[(size_t)(k0 + 2 * i + (lane >> 5)) * N + ncol0 + n0 + (lane & 31)];
#pragma unroll
    for (int i = 0; i < 32; ++i) scr[(2 * i + (lane >> 5)) * 33 + (lane & 31)] = wv[i];
    asm volatile("s_waitcnt lgkmcnt(0)" ::: "memory");
    const int c = lane & 7;
#pragma unroll
    for (int j = 0; j < 4; ++j) { const int n = (lane >> 3) + 8 * j; const LAS float* s = scr + (8 * c) * 33 + n;
        u32x2 o; o.x = cvt4_fp8(64.f * s[0 * 33], 64.f * s[1 * 33], 64.f * s[2 * 33], 64.f * s[3 * 33]); o.y = cvt4_fp8(64.f * s[4 * 33], 64.f * s[5 * 33], 64.f * s[6 * 33], 64.f * s[7 * 33]);
        *(u32x2*)(WT8 + (size_t)(n0 + n) * K + k0 + 8 * c) = o; }
    asm volatile("s_waitcnt lgkmcnt(0)" ::: "memory");
}

struct Params {
    const float* in[23]; float* out; unsigned char* ws;
};

__device__ __forceinline__ void convert_weights(const Params& P, int li, LAS unsigned char* lds, int gw, int NGW, int lane, int wid, int part = 0) {
    LAS float* scr = (LAS float*)(lds + wid * 16384);
    const float* w_in = P.in[2] + (size_t)li * DM * NCOLS; const float* w_ao = P.in[3] + (size_t)li * AW * DM; const float* w_so = P.in[4] + (size_t)li * AW * DM;
    const float* w_out = P.in[5] + (size_t)li * DM * DM; const float* w_ple = P.in[6] + (size_t)li * PLE * DM; const float* w_glu = P.in[20] + (size_t)li * AW * AW;
    constexpr int I_IN = (DM / 64) * (NCOLS / 32), I_AO = (AW / 64) * (DM / 32), I_OUT = (DM / 64) * (DM / 32), I_PLE = (PLE / 64) * (DM / 32), I_GLU = (AW / 64) * (AW / 32);
    constexpr int NF8 = 24, I_F8 = (DM / 64) * (NF8 * 8);
    constexpr int NITEMS = I_IN + 2 * I_AO + I_OUT + I_PLE + I_GLU + I_F8;
    for (int it = gw; it < NITEMS; it += NGW) {
        int r = it;
        { const bool is_win = (r < I_IN) || (r >= NITEMS - I_F8); if ((part == 1 && !is_win) || (part == 2 && is_win)) continue; }
        if (r >= NITEMS - I_F8) { const int q = r - (NITEMS - I_F8), kb = q / (NF8 * 8), nb = q % (NF8 * 8); unsigned long long mm = FP8_TILES; for (int k = 0; k < (nb >> 3); ++k) mm &= mm - 1; const int pn = __builtin_ctzll(mm);
            transpose_item_fp8(w_in, DM, NCOLS, pn * 256, 8, P.ws + WS_WIN + (size_t)pn * MiB, scr, kb * 8 + (nb & 7), lane); continue; }
        if (r < I_IN) { if (!((FP8_TILES >> ((r % (NCOLS / 32)) >> 3)) & 1ull)) transpose_item(w_in, DM, NCOLS, (bf16_t*)(P.ws + WS_WIN), scr, r, lane); continue; } r -= I_IN;
        if (r < I_AO) { transpose_item(w_ao, AW, DM, (bf16_t*)(P.ws + WS_WAO), scr, r, lane); continue; } r -= I_AO;
        if (r < I_AO) { transpose_item(w_so, AW, DM, (bf16_t*)(P.ws + WS_WSO), scr, r, lane); continue; } r -= I_AO;
        if (r < I_OUT) { transpose_item(w_out, DM, DM, (bf16_t*)(P.ws + WS_WOUT), scr, r, lane); continue; } r -= I_OUT;
        if (r < I_PLE) { transpose_item(w_ple, PLE, DM, (bf16_t*)(P.ws + WS_WPLE), scr, r, lane); continue; } r -= I_PLE;
        transpose_item_fp8(w_glu, AW, AW, 0, AW / 32, P.ws + WS_WGLU, scr, r, lane);
    }
    if (part == 1) return;
    const float* pp = P.in[1] + (size_t)li * T * PLE; bf16_t* pb = (bf16_t*)(P.ws + WS_PB);
    const size_t n8 = (size_t)T * PLE / 8, gt = (size_t)gw * 64 + lane, NT_ = (size_t)NGW * 64;
#pragma unroll 4
    for (size_t i = gt; i < n8; i += NT_) { const f32x4 a = *(const f32x4*)(pp + i * 8), b = *(const f32x4*)(pp + i * 8 + 4);
        u32x4 w; w.x = cvtpk(a[0], a[1]); w.y = cvtpk(a[2], a[3]); w.z = cvtpk(b[0], b[1]); w.w = cvtpk(b[2], b[3]); *(u32x4*)(pb + i * 8) = w; }
}

__device__ __forceinline__ float wave_sum(float v, int lane) {
#pragma unroll
    for (int o = 1; o < 64; o <<= 1) v += __int_as_float(__builtin_amdgcn_ds_bpermute((lane ^ o) << 2, __float_as_int(v)));
    return v;
}
__device__ __forceinline__ float xor32_max(float v) { auto rr = __builtin_amdgcn_permlane32_swap(__float_as_uint(v), __float_as_uint(v), false, false); return fmaxf(__uint_as_float(rr[0]), __uint_as_float(rr[1])); }
__device__ __forceinline__ float xor32_sum(float v) { auto rr = __builtin_amdgcn_permlane32_swap(__float_as_uint(v), __float_as_uint(v), false, false); return __uint_as_float(rr[0]) + __uint_as_float(rr[1]); }

__device__ __forceinline__ void ln_rows(float* h, const float* g, const float* b, bf16_t* xb, unsigned char* xb8, int gw, int NGW, int lane) {
    f32x4 gv[8], bv[8];
#pragma unroll
    for (int j = 0; j < 8; ++j) { gv[j] = *(const f32x4*)(g + 4 * lane + 256 * j); bv[j] = *(const f32x4*)(b + 4 * lane + 256 * j); }
    for (int m = gw; m < T; m += NGW) {
        float* row = h + (size_t)m * DM; f32x4 v[8]; float s = 0.f;
#pragma unroll
        for (int j = 0; j < 8; ++j) { v[j] = *(const f32x4*)(row + 4 * lane + 256 * j); s += (v[j][0] + v[j][1]) + (v[j][2] + v[j][3]); }
        const float mean = wave_sum(s, lane) * (1.f / DM); float s2 = 0.f;
#pragma unroll
        for (int j = 0; j < 8; ++j) { v[j] = v[j] - mean; s2 += (v[j][0] * v[j][0] + v[j][1] * v[j][1]) + (v[j][2] * v[j][2] + v[j][3] * v[j][3]); }
        const float rstd = 1.f / sqrtf(wave_sum(s2, lane) * (1.f / DM) + 1e-5f);
#pragma unroll
        for (int j = 0; j < 8; ++j) { const f32x4 o = v[j] * rstd * gv[j] + bv[j]; *(f32x4*)(row + 4 * lane + 256 * j) = o;
            if (xb) { u32x2 w; w.x = cvt_pk_bf16(o[0], o[1]); w.y = cvt_pk_bf16(o[2], o[3]); *(u32x2*)(xb + (size_t)m * DM + 4 * lane + 256 * j) = w;
                *(unsigned*)(xb8 + (size_t)m * DM + 4 * lane + 256 * j) = cvt4_fp8(o[0], o[1], o[2], o[3]); } }
    }
}

constexpr int LN_LDS = 131072 + 128;
constexpr size_t WS_LNSTAT = 1016 * MiB;
constexpr int CTL_LNCNT = 256;
struct EpiOutLn {
    static constexpr bool PERM = true, FUSED = true;
    const float* res; float* out; const bf16_t* ple; const float* g; const float* b; bf16_t* xb; unsigned char* xb8; unsigned long long* stats; unsigned* cnt;
    __device__ __forceinline__ void fused(f32x4 (&acc)[2][2][4][2], const pg8::Unit& u, int wr, int wc, LAS unsigned char* lds) const {
        int t2 = threadIdx.x; asm volatile("" : "+v"(t2));
        const int lane = t2 & 63, fr = t2 & 15, fq = (t2 >> 4) & 3, wid = __builtin_amdgcn_readfirstlane(t2 >> 6);
        LAS float* rs = (LAS float*)(lds + LN_LDS); LAS float* tab = rs + 2048;
        const int row0 = u.pm * 256 + wr * 64 + fr, col0 = u.pn * 256 + wc * 32 + 8 * fq;
#pragma unroll
        for (int ai = 0; ai < 2; ++ai)
#pragma unroll
            for (int m = 0; m < 4; ++m) { const size_t roff = (size_t)(row0 + ai * 128 + m * 16) * DM + col0; float s1 = 0.f, s2 = 0.f;
#pragma unroll
                for (int bj = 0; bj < 2; ++bj) { const size_t off = roff + bj * 128;
                    const f32x4 r0 = *(const f32x4*)(res + off), r1 = *(const f32x4*)(res + off + 4); const u32x4 pl = *(const u32x4*)(ple + off);
                    f32x4 h0 = acc[ai][bj][m][0], h1 = acc[ai][bj][m][1];
                    h0[0] += r0[0] * ALPHA_RES + bf_lo(pl[0]); h0[1] += r0[1] * ALPHA_RES + bf_hi(pl[0]); h0[2] += r0[2] * ALPHA_RES + bf_lo(pl[1]); h0[3] += r0[3] * ALPHA_RES + bf_hi(pl[1]);
                    h1[0] += r1[0] * ALPHA_RES + bf_lo(pl[2]); h1[1] += r1[1] * ALPHA_RES + bf_hi(pl[2]); h1[2] += r1[2] * ALPHA_RES + bf_lo(pl[3]); h1[3] += r1[3] * ALPHA_RES + bf_hi(pl[3]);
                    acc[ai][bj][m][0] = h0; acc[ai][bj][m][1] = h1;
                    s1 += (h0[0] + h0[1]) + (h0[2] + h0[3]) + (h1[0] + h1[1]) + (h1[2] + h1[3]);
                    s2 += (h0[0] * h0[0] + h0[1] * h0[1]) + (h0[2] * h0[2] + h0[3] * h0[3]) + (h1[0] * h1[0] + h1[1] * h1[1]) + (h1[2] * h1[2] + h1[3] * h1[3]); }
                s1 += __int_as_float(__builtin_amdgcn_ds_bpermute((lane ^ 16) << 2, __float_as_int(s1))); s2 += __int_as_float(__builtin_amdgcn_ds_bpermute((lane ^ 16) << 2, __float_as_int(s2)));
                s1 = xor32_sum(s1); s2 = xor32_sum(s2);
                if (fq == 0) { const int r = ai * 128 + wr * 64 + m * 16 + fr; rs[(r * 4 + wc) * 2] = s1; rs[(r * 4 + wc) * 2 + 1] = s2; }
                asm volatile("" ::: "memory"); }
        asm volatile("s_waitcnt lgkmcnt(0)" ::: "memory"); __builtin_amdgcn_s_barrier(); asm volatile("" ::: "memory");
        if (t2 < 256) { const int r = t2; const float a = (rs[(r * 4) * 2] + rs[(r * 4 + 1) * 2]) + (rs[(r * 4 + 2) * 2] + rs[(r * 4 + 3) * 2]);
            const float q = (rs[(r * 4) * 2 + 1] + rs[(r * 4 + 1) * 2 + 1]) + (rs[(r * 4 + 2) * 2 + 1] + rs[(r * 4 + 3) * 2 + 1]);
            __hip_atomic_store(stats + ((size_t)(u.pm * 256 + r) * 8 + u.pn), ((unsigned long long)__float_as_uint(q) << 32) | __float_as_uint(a), __ATOMIC_RELAXED, __HIP_MEMORY_SCOPE_AGENT); }
        asm volatile("s_waitcnt vmcnt(0)" ::: "memory");
        if (t2 < 256 && lane == 0) __hip_atomic_fetch_add(cnt + u.pm, 1u, __ATOMIC_RELAXED, __HIP_MEMORY_SCOPE_AGENT);
        if (wid == 0) { unsigned sp = 0;
            while ((unsigned)__builtin_amdgcn_readfirstlane(__hip_atomic_load(cnt + u.pm, __ATOMIC_RELAXED, __HIP_MEMORY_SCOPE_AGENT)) < 32u) { __builtin_amdgcn_s_sleep(2); if (++sp > (1u << 22)) break; }
            __builtin_amdgcn_fence(__ATOMIC_ACQUIRE, "agent"); asm volatile("s_waitcnt vmcnt(0)" ::: "memory"); }
        asm volatile("s_waitcnt lgkmcnt(0)" ::: "memory"); __builtin_amdgcn_s_barrier(); asm volatile("" ::: "memory");
        if (t2 < 256) { const int r = t2; const unsigned long long* sl_ = stats + (size_t)(u.pm * 256 + r) * 8; float a = 0.f, q = 0.f;
#pragma unroll
            for (int k = 0; k < 8; ++k) { const unsigned long long w = __hip_atomic_load(sl_ + k, __ATOMIC_RELAXED, __HIP_MEMORY_SCOPE_AGENT); a += __uint_as_float((unsigned)w); q += __uint_as_float((unsigned)(w >> 32)); }
            const float mean = a * (1.f / DM), var = q * (1.f / DM) - mean * mean; tab[r * 2] = mean; tab[r * 2 + 1] = 1.f / sqrtf(fmaxf(var, 0.f) + 1e-5f); }
        asm volatile("s_waitcnt lgkmcnt(0)" ::: "memory"); __builtin_amdgcn_s_barrier(); asm volatile("" ::: "memory");
#pragma unroll
        for (int bj = 0; bj < 2; ++bj) { const int c = col0 + bj * 128;
            const f32x4 g0 = *(const f32x4*)(g + c), g1 = *(const f32x4*)(g + c + 4), b0 = *(const f32x4*)(b + c), b1 = *(const f32x4*)(b + c + 4);
#pragma unroll
            for (int ai = 0; ai < 2; ++ai)
#pragma unroll
                for (int m = 0; m < 4; ++m) { const int r = ai * 128 + wr * 64 + m * 16 + fr; const float mean = tab[r * 2], rstd = tab[r * 2 + 1];
                    const size_t off = (size_t)(u.pm * 256 + r) * DM + c;
                    const f32x4 o0 = (acc[ai][bj][m][0] - mean) * rstd * g0 + b0, o1 = (acc[ai][bj][m][1] - mean) * rstd * g1 + b1;
                    *(f32x4*)(out + off) = o0; *(f32x4*)(out + off + 4) = o1;
                    if (xb) { u32x4 w; w.x = cvtpk(o0[0], o0[1]); w.y = cvtpk(o0[2], o0[3]); w.z = cvtpk(o1[0], o1[1]); w.w = cvtpk(o1[2], o1[3]); *(u32x4*)(xb + off) = w;
                        *(u32x2*)(xb8 + off) = (u32x2){cvt4_fp8(o0[0], o0[1], o0[2], o0[3]), cvt4_fp8(o1[0], o1[1], o1[2], o1[3])}; }
                    asm volatile("" ::: "memory"); } }
    }
};

__device__ __forceinline__ void ssm_tables(const Params& P, int li, LAS unsigned char* lds, int item) {
    int tid = threadIdx.x; asm volatile("" : "+v"(tid));
    const int g = item >> 2, part = item & 3;
    LAS float* zre = (LAS float*)lds; LAS float* zim = zre + 65 * 64;
    LAS float* bre = zim + 65 * 64; LAS float* bim = bre + 1024;
    LAS float* cre = bim + 1024; LAS float* cim = cre + 1024;
    const float* a_re = P.in[12] + (size_t)li * NG * 64 + g * 64; const float* a_im = P.in[13] + (size_t)li * NG * 64 + g * 64;
    const float dt = expf(P.in[14][li * NG + g]);
    const float* b_re = P.in[15] + ((size_t)li * NG + g) * 1024; const float* b_im = P.in[16] + ((size_t)li * NG + g) * 1024;
    const float* c_re = P.in[17] + ((size_t)li * NG + g) * 1024; const float* c_im = P.in[18] + ((size_t)li * NG + g) * 1024;
    __syncthreads();
    for (int idx = tid; idx < 1024; idx += 512) {
        const int p = idx >> 4;
        const float ar = a_re[p], ai = a_im[p]; const float mag = expf(ar * dt), ph = ai * dt; float sn, cs; sincosf(ph, &sn, &cs);
        const float abr = mag * cs, abi = mag * sn, nr = abr - 1.0f, ni = abi, den = ar * ar + ai * ai;
        const float fr = (nr * ar + ni * ai) / den, fi = (ni * ar - nr * ai) / den;
        const float br = b_re[idx], bi = b_im[idx];
        bre[idx] = fr * br - fi * bi; bim[idx] = fr * bi + fi * br;
        cre[idx] = c_re[idx]; cim[idx] = c_im[idx];
        if ((idx & 15) == 0) {
            float zr = 1.f, zi = 0.f;
            for (int t = 0; t <= 64; ++t) { zre[t * 64 + p] = zr; zim[t * 64 + p] = zi; const float nzr = zr * abr - zi * abi, nzi = zr * abi + zi * abr; zr = nzr; zi = nzi; }
            if (part == 0) { float* a64 = (float*)(P.ws + WS_A64) + (g * 64 + p) * 2; a64[0] = zre[64 * 64 + p]; a64[1] = zim[64 * 64 + p]; }
        }
    }
    __syncthreads();
    bf16_t* ktab = (bf16_t*)(P.ws + WS_KTAB) + (size_t)g * 65 * 256;
    if (part == 0 && tid < 256) ktab[64 * 256 + tid] = 0;
    for (int e = tid; e < 16 * 256; e += 512) {
        const int tau = part * 16 + (e >> 8), h = (e >> 4) & 15, h2 = e & 15; float s = 0.f;
        for (int p = 0; p < 64; ++p) { const float zr = zre[tau * 64 + p], zi = zim[tau * 64 + p], cr = cre[h * 64 + p], ci = cim[h * 64 + p];
            const float czr = cr * zr - ci * zi, czi = cr * zi + ci * zr; s += czr * bre[p * 16 + h2] - czi * bim[p * 16 + h2]; }
        ktab[tau * 256 + h * 16 + h2] = (bf16_t)(cvt_pk_bf16(s, 0.f) & 0xffff);
    }
    bf16_t* etab = (bf16_t*)(P.ws + WS_ETAB) + (size_t)g * 1024 * 128;
    for (int e = tid; e < 256 * 128; e += 512) {
        const int row = part * 256 + (e >> 7), col = e & 127, t = row >> 4, h = row & 15, p = col >> 1;
        const float zr = zre[(t + 1) * 64 + p], zi = zim[(t + 1) * 64 + p], cr = cre[h * 64 + p], ci = cim[h * 64 + p];
        const float v = (col & 1) ? -(cr * zi + ci * zr) : (cr * zr - ci * zi);
        etab[(size_t)row * 128 + col] = (bf16_t)(cvt_pk_bf16(v, 0.f) & 0xffff);
    }
    bf16_t* ftab = (bf16_t*)(P.ws + WS_FTAB) + (size_t)g * 128 * 1024;
    for (int e = tid; e < 128 * 256; e += 512) {
        const int row = e >> 8, col = part * 256 + (e & 255), p = row >> 1, s = col >> 4, h2 = col & 15;
        const float zr = zre[(63 - s) * 64 + p], zi = zim[(63 - s) * 64 + p], br = bre[p * 16 + h2], bi = bim[p * 16 + h2];
        const float v = (row & 1) ? (zr * bi + zi * br) : (zr * br - zi * bi);
        ftab[(size_t)row * 1024 + col] = (bf16_t)(cvt_pk_bf16(v, 0.f) & 0xffff);
    }
    __syncthreads();
}

__device__ __forceinline__ void ssm_local(const Params& P, int item, int lane) {
    const int rt = item & 3, cg_ = (item >> 2) & 15, g = item >> 6, r32 = lane & 31, hi = lane >> 5;
    const bf16_t* F = (const bf16_t*)(P.ws + WS_FTAB) + ((size_t)g * 128 + rt * 32 + r32) * 1024 + hi * 8;
    const bf16_t* U = (const bf16_t*)(P.ws + WS_U) + ((size_t)(cg_ * 32 + r32) * 64) * 1024 + g * 16 + hi * 8;
    f32x16 acc = {};
#pragma unroll 16
    for (int s = 0; s < 64; ++s) { const bf16x8 a = *(const bf16x8*)(F + s * 16); const bf16x8 b = *(const bf16x8*)(U + (size_t)s * 1024);
        acc = __builtin_amdgcn_mfma_f32_32x32x16_bf16(a, b, acc, 0, 0, 0); }
    float* xl = (float*)(P.ws + WS_XLOC) + ((size_t)(cg_ * 32 + r32) * 64 + g) * 128 + rt * 32 + 4 * hi;
#pragma unroll
    for (int q = 0; q < 4; ++q) *(f32x4*)(xl + 8 * q) = (f32x4){acc[4 * q], acc[4 * q + 1], acc[4 * q + 2], acc[4 * q + 3]};
}

__device__ __forceinline__ void ssm_scan(const Params& P, int gt) {
    const int b = gt >> 12, g = (gt >> 6) & 63, p = gt & 63;
    const f32x2 a = *(const f32x2*)((const float*)(P.ws + WS_A64) + (g * 64 + p) * 2);
    const float* xl = (const float*)(P.ws + WS_XLOC) + ((size_t)(b * 256) * 64 + g) * 128 + 2 * p;
    unsigned* xs = (unsigned*)((bf16_t*)(P.ws + WS_XS) + ((size_t)(b * 256) * 64 + g) * 128 + 2 * p);
    float xr = 0.f, xi = 0.f;
#pragma unroll 32
    for (int c = 0; c < 256; ++c) {
        const f32x2 l = *(const f32x2*)(xl + (size_t)c * 64 * 128);
        xs[(size_t)c * 64 * 64] = cvt_pk_bf16(xr, xi);
        const float nr = a[0] * xr - a[1] * xi + l[0], ni = a[0] * xi + a[1] * xr + l[1]; xr = nr; xi = ni;
    }
}

constexpr int SY_KT = 0, SY_U = 65 * 512, SY_UP = 2064;
__device__ __forceinline__ void ssm_y_unit(const Params& P, int li, LAS unsigned char* lds, int unit) {
    int tid = threadIdx.x; asm volatile("" : "+v"(tid));
    const int g = unit >> 4, cg_ = unit & 15, lane = tid & 63, wid = __builtin_amdgcn_readfirstlane(tid >> 6), r32 = lane & 31, hi = lane >> 5;
    __syncthreads();
    {
        const u32x4* src = (const u32x4*)((const bf16_t*)(P.ws + WS_KTAB) + (size_t)g * 65 * 256);
        for (int i = tid; i < 2080; i += 512) *(LAS u32x4*)(lds + SY_KT + i * 16) = src[i];
        const bf16_t* U = (const bf16_t*)(P.ws + WS_U);
        for (int i = tid; i < 4096; i += 512) { const int c = i >> 7, s = (i >> 1) & 63, hf = i & 1;
            const u32x4 v = *(const u32x4*)(U + ((size_t)((cg_ * 32 + c) * 64 + s)) * 1024 + g * 16 + hf * 8);
            *(LAS u32x4*)(lds + SY_U + c * SY_UP + s * 32 + hf * 16) = v; }
    }
    bf16x8 xsf[8];
    { const bf16_t* xs = (const bf16_t*)(P.ws + WS_XS) + ((size_t)(cg_ * 32 + r32) * 64 + g) * 128 + hi * 8;
#pragma unroll
      for (int k = 0; k < 8; ++k) xsf[k] = *(const bf16x8*)(xs + k * 16); }
    __syncthreads();
    const float* dsk = P.in[19] + (size_t)li * 1024 + g * 16;
    const int hrow = r32 & 15, trow = r32 >> 4;
    for (int j = 0; j < 4; ++j) {
        const int ti = (j == 0) ? wid : (j == 1) ? 15 - wid : (j == 2) ? 16 + wid : 31 - wid;
        f32x16 acc = {};
        const int ns = 2 * ti + 2;
        const LAS unsigned char* ub = lds + SY_U + r32 * SY_UP + hi * 16;
        const LAS unsigned char* kb = lds + SY_KT + hrow * 32 + hi * 16;
        f32x16 acc2 = {};
        for (int s = 0; s < ns; s += 2) {
            int tau = 2 * ti + trow - s; const int tau0 = tau < 0 ? 64 : tau, tau1 = tau - 1 < 0 ? 64 : tau - 1;
            const bf16x8 a0 = *(const LAS bf16x8*)(kb + tau0 * 512), a1 = *(const LAS bf16x8*)(kb + tau1 * 512);
            const bf16x8 b0 = *(const LAS bf16x8*)(ub + s * 32), b1 = *(const LAS bf16x8*)(ub + s * 32 + 32);
            acc = __builtin_amdgcn_mfma_f32_32x32x16_bf16(a0, b0, acc, 0, 0, 0);
            acc2 = __builtin_amdgcn_mfma_f32_32x32x16_bf16(a1, b1, acc2, 0, 0, 0);
        }
        const bf16_t* E = (const bf16_t*)(P.ws + WS_ETAB) + ((size_t)g * 1024 + ti * 32 + r32) * 128 + hi * 8;
#pragma unroll
        for (int k = 0; k < 8; k += 2) { const bf16x8 a0 = *(const bf16x8*)(E + k * 16), a1 = *(const bf16x8*)(E + k * 16 + 16);
            acc = __builtin_amdgcn_mfma_f32_32x32x16_bf16(a0, xsf[k], acc, 0, 0, 0); acc2 = __builtin_amdgcn_mfma_f32_32x32x16_bf16(a1, xsf[k + 1], acc2, 0, 0, 0); }
        acc += acc2;
        bf16_t* yg = (bf16_t*)(P.ws + WS_YG);
#pragma unroll
        for (int q = 0; q < 4; ++q) {
            const int row = 8 * q + 4 * hi, t = 2 * ti + (row >> 4), h0 = row & 15;
            const u32x2 uu = *(const LAS u32x2*)(lds + SY_U + r32 * SY_UP + t * 32 + h0 * 2);
            const f32x4 d4 = *(const f32x4*)(dsk + h0);
            float y0 = acc[4 * q] + d4[0] * bf_lo(uu[0]), y1 = acc[4 * q + 1] + d4[1] * bf_hi(uu[0]), y2 = acc[4 * q + 2] + d4[2] * bf_lo(uu[1]), y3 = acc[4 * q + 3] + d4[3] * bf_hi(uu[1]);
            const float g0 = gelu_tanh(y0), g1 = gelu_tanh(y1), g2 = gelu_tanh(y2), g3 = gelu_tanh(y3);
            u32x2 w; w.x = cvt_pk_bf16(g0, g1); w.y = cvt_pk_bf16(g2, g3);
            const size_t yo = ((size_t)((cg_ * 32 + r32) * 64 + t)) * 1024 + g * 16 + h0;
            *(u32x2*)(yg + yo) = w; *(unsigned*)(P.ws + WS_YG8 + yo) = cvt4_fp8(g0, g1, g2, g3);
        }
    }
}

constexpr int AT_STG = 32768, AT_NST = 4;
constexpr int AT_CTL = AT_NST * AT_STG;
constexpr float AT_DEFER = 8.f;
constexpr float AT_MASS = 26.f;
constexpr int CTL_KMAX = 0, CTL_QCTR = 64;
__device__ __forceinline__ void kmax_task(const Params& P, int task, int lane) {
    const int chunk = task >> 4, hm = task & 15; const size_t token = (size_t)chunk * 64 + lane;
    const u32x4* kp = (const u32x4*)((const bf16_t*)(P.ws + WS_K) + token * 1024 + hm * 64);
    float ss = 0.f;
#pragma unroll
    for (int i = 0; i < 8; ++i) { const u32x4 v = kp[i];
#pragma unroll
        for (int j = 0; j < 4; ++j) { const float a = bf_lo(v[j]), b2 = bf_hi(v[j]); ss += a * a + b2 * b2; } }
#pragma unroll
    for (int o = 1; o < 64; o <<= 1) ss = fmaxf(ss, __int_as_float(__builtin_amdgcn_ds_bpermute((lane ^ o) << 2, __float_as_int(ss))));
    if (lane == 0) atomicMax((unsigned*)P.ws + CTL_KMAX + (chunk >> 8) * 16 + hm, __float_as_uint(ss));
}
__device__ __forceinline__ void attn_unit(const Params& P, int li, LAS unsigned char* lds, int b, int h, int qb, float lam, float one_m_li) {
    int tid = threadIdx.x; asm volatile("" : "+v"(tid));
    const int lane = tid & 63, wid = __builtin_amdgcn_readfirstlane(tid >> 6), r32 = lane & 31, hi = lane >> 5, mp = wid >> 2, wq = wid & 3;
    const bf16_t* Qg = (const bf16_t*)(P.ws + WS_Q); const bf16_t* Kg = (const bf16_t*)(P.ws + WS_K); const bf16_t* VTg = (const bf16_t*)(P.ws + WS_VT);
    const int NT = qb * 2 + 2, cw = qb * 2 + (wq >> 1);
    const float sl = __uint_as_float((unsigned)(127 - (h + 1)) << 23) * LOG2E;
    const float sl3 = 3.f * sl, sl8 = 8.f * sl, sl24 = 24.f * sl, sl32 = 32.f * sl;
    const float thr = AT_MASS - __builtin_amdgcn_logf(1.0f - ex2(-sl)) + 0.01f;
    const int qpos = qb * 128 + wq * 32 + r32;
    const size_t tok = (size_t)b * SEQ + qpos;
    const float qinf = (float)((wq & 1) * 32 + r32) - 4.f * (float)hi;
    const int srow = wid * 8 + (lane >> 3), lch = (lane & 7) ^ ((srow >> 1) & 7);
    const bf16_t* kg0 = Kg + ((size_t)b * SEQ + srow) * 1024 + h * 128 + lch * 8;
    const bf16_t* vg0 = VTg + ((size_t)(h * 128 + srow)) * T + (size_t)b * SEQ + lch * 8;
    const unsigned ldsw = (unsigned)wid * 1024u;
#define AT_ISSUE(t_, st_) do { LAS unsigned char* sb_ = lds + (st_) * AT_STG + ldsw; \
        __builtin_amdgcn_global_load_lds((const unsigned*)(kg0 + (size_t)(t_) * 65536), (LAS unsigned*)(sb_), 16, 0, 0); \
        __builtin_amdgcn_global_load_lds((const unsigned*)(kg0 + (size_t)(t_) * 65536 + 64), (LAS unsigned*)(sb_ + 8192), 16, 0, 0); \
        __builtin_amdgcn_global_load_lds((const unsigned*)(vg0 + (t_) * 64), (LAS unsigned*)(sb_ + 16384), 16, 0, 0); \
        __builtin_amdgcn_global_load_lds((const unsigned*)(vg0 + (size_t)64 * T + (t_) * 64), (LAS unsigned*)(sb_ + 24576), 16, 0, 0); } while (0)
    LAS unsigned* ctl = (LAS unsigned*)(lds + AT_CTL);
    if (tid == 0) ctl[0] = 0x7fffffffu;
    bf16x8 qr[4];
#pragma unroll
    for (int d0 = 0; d0 < 4; ++d0) qr[d0] = *(const bf16x8*)(Qg + tok * 1024 + h * 128 + mp * 64 + d0 * 16 + hi * 8);
    asm volatile("" ::: "memory");
    AT_ISSUE(NT - 1, 0); AT_ISSUE(NT - 2, 1);
    float qn;
    { float s2 = 0.f;
#pragma unroll
      for (int d0 = 0; d0 < 4; ++d0)
#pragma unroll
          for (int j = 0; j < 8; ++j) { const float v = bf1((bf16_t)qr[d0][j]); s2 += v * v; }
      qn = sqrtf(xor32_sum(s2)); }
    const float kmx = sqrtf(__uint_as_float(__hip_atomic_load((unsigned*)P.ws + CTL_KMAX + b * 16 + h * 2 + mp, __ATOMIC_RELAXED, __HIP_MEMORY_SCOPE_AGENT)));
    const int sw = (r32 >> 1) & 7;
    int coff[4];
#pragma unroll
    for (int k = 0; k < 4; ++k) coff[k] = ((2 * k + hi) ^ sw) << 4;
    f32x16 o[4]; o[0] = f32x16{}; o[1] = f32x16{}; o[2] = f32x16{}; o[3] = f32x16{};
    float m = -1e30f, l = 0.f;
    bf16x8 pf[4];
    bool havepf = false;
    float bw = 1e30f;
#define AT_EXP(r_) do { p0[r_] = ex2(p0[r_]); p1[r_] = ex2(p1[r_]); lsa[(r_) & 1] = fadd_s(lsa[(r_) & 1], p0[r_]); lsb[(r_) & 1] = fadd_s(lsb[(r_) & 1], p1[r_]); } while (0)
#define AT_PACK() do { _Pragma("unroll") for (int s = 0; s < 2; ++s) { u32x4 w0, w1; \
            w0.x = cvtpk(p0[8 * s], p0[8 * s + 1]); w0.y = cvtpk(p0[8 * s + 2], p0[8 * s + 3]); w0.z = cvtpk(p0[8 * s + 4], p0[8 * s + 5]); w0.w = cvtpk(p0[8 * s + 6], p0[8 * s + 7]); \
            w1.x = cvtpk(p1[8 * s], p1[8 * s + 1]); w1.y = cvtpk(p1[8 * s + 2], p1[8 * s + 3]); w1.z = cvtpk(p1[8 * s + 4], p1[8 * s + 5]); w1.w = cvtpk(p1[8 * s + 6], p1[8 * s + 7]); \
            pf[s] = __builtin_bit_cast(bf16x8, w0); pf[2 + s] = __builtin_bit_cast(bf16x8, w1); } } while (0)
    asm volatile("s_waitcnt vmcnt(0) lgkmcnt(0)" ::: "memory"); __builtin_amdgcn_s_barrier(); asm volatile("" ::: "memory");
    int iend = NT, i = 0;
#pragma unroll 1
    for (; i < iend; ++i) {
        const int t = NT - 1 - i;
        asm volatile("s_waitcnt vmcnt(0) lgkmcnt(0)" ::: "memory");
        __builtin_amdgcn_s_barrier();
        asm volatile("" ::: "memory");
        if (i == 2) { const int tstop = (int)ctl[0]; const int ie = NT - (tstop < NT - 2 ? tstop : NT - 2); iend = ie; if (i >= ie) break; }
        if (t >= 2) AT_ISSUE(t - 2, (i + 2) & 3);
        const LAS unsigned char* cb = lds + (i & 3) * AT_STG;
        if (t <= cw) {
            f32x16 p0, p1;
            const LAS unsigned char* kp = cb + mp * 8192 + r32 * 128;
            bf16x8 kf[8];
#pragma unroll
            for (int d0 = 0; d0 < 4; ++d0) { kf[2 * d0] = *(const LAS bf16x8*)(kp + coff[d0]); kf[2 * d0 + 1] = *(const LAS bf16x8*)(kp + 4096 + coff[d0]); }
            const bool diag = (t == cw);
            if (diag) { p0 = f32x16{}; p1 = f32x16{}; }
            else {
                const float nc0 = -(sl * ((float)((cw - t) * 64) + qinf) + m), nc1 = fadd_s(nc0, sl32);
                float b0[4], b1[4];
                b0[0] = nc0; b0[1] = fadd_s(nc0, sl8); b0[2] = fma2_s(sl8, nc0); b0[3] = fadd_s(nc0, sl24);
                b1[0] = nc1; b1[1] = fadd_s(nc1, sl8); b1[2] = fma2_s(sl8, nc1); b1[3] = fadd_s(nc1, sl24);
#pragma unroll
                for (int q = 0; q < 4; ++q) {
                    p0[4 * q] = b0[q]; p0[4 * q + 1] = fadd_s(b0[q], sl); p0[4 * q + 2] = fma2_s(sl, b0[q]); p0[4 * q + 3] = fadd_s(b0[q], sl3);
                    p1[4 * q] = b1[q]; p1[4 * q + 1] = fadd_s(b1[q], sl); p1[4 * q + 2] = fma2_s(sl, b1[q]); p1[4 * q + 3] = fadd_s(b1[q], sl3);
                }
            }
            __builtin_amdgcn_sched_barrier(0);
            __builtin_amdgcn_s_setprio(1);
#pragma unroll
            for (int d0 = 0; d0 < 4; ++d0) {
                p0 = __builtin_amdgcn_mfma_f32_32x32x16_bf16(kf[2 * d0], qr[d0], p0, 0, 0, 0);
                p1 = __builtin_amdgcn_mfma_f32_32x32x16_bf16(kf[2 * d0 + 1], qr[d0], p1, 0, 0, 0);
            }
            __builtin_amdgcn_s_setprio(0);
            if (diag) {
                float qf = qinf; asm volatile("" : "+v"(qf));
#pragma unroll
                for (int r = 0; r < 16; ++r) { const float d0 = qf - (float)crow(r, 0);
                    p0[r] = fmaf(-sl, fabsf(d0), p0[r]); p1[r] = fmaf(-sl, fabsf(d0 - 32.f), p1[r]); }
            }
            const bool skipmax = !diag && (bw - sl * (float)((cw - t) * 64 - 63) <= AT_DEFER);
            float mt = -1.f;
            if (!skipmax) {
                float mx = max3f(p0[0], p1[0], p0[1]);
#pragma unroll
                for (int r = 1; r < 15; ++r) mx = max3f(mx, p1[r], p0[r + 1]);
                mx = max3f(mx, p1[15], mx);
                mt = xor32_max(mx);
            }
            bool resc; float ra;
            if (diag) {
                resc = true; ra = ex2(m - mt); m = mt;
#pragma unroll
                for (int r = 0; r < 16; ++r) { p0[r] -= mt; p1[r] -= mt; }
                { float bb = qn * kmx - m;
#pragma unroll
                  for (int o_ = 1; o_ < 32; o_ <<= 1) bb = fmaxf(bb, __int_as_float(__builtin_amdgcn_ds_bpermute((lane ^ o_) << 2, __float_as_int(bb))));
                  bw = __uint_as_float(__builtin_amdgcn_readfirstlane(__float_as_uint(bb))); }
                const float X = qn * kmx - m + thr; const float ts = floorf(((float)(qpos - 63) - X / sl) * (1.f / 64.f));
                const unsigned tsu = ts > 0.f ? (unsigned)ts : 0u; __hip_atomic_fetch_min(ctl, tsu, __ATOMIC_RELAXED, __HIP_MEMORY_SCOPE_WORKGROUP);
            } else {
                resc = !skipmax && __any(mt > AT_DEFER); ra = 1.f;
                if (resc) {
                    const float dl = fmaxf(mt, 0.f); ra = ex2(-dl); m += dl;
#pragma unroll
                    for (int r = 0; r < 16; ++r) { p0[r] -= dl; p1[r] -= dl; }
                }
            }
            float lsa[2] = {0.f, 0.f}, lsb[2] = {0.f, 0.f};
            if (havepf) {
                const LAS unsigned char* vp = lds + ((i + 3) & 3) * AT_STG + 16384 + r32 * 128;
                asm volatile("" : "+v"(p0), "+v"(p1));
                bf16x8 va[2][2];
#pragma unroll
                for (int d = 0; d < 2; ++d) va[0][d] = *(const LAS bf16x8*)(vp + d * 4096 + coff[0]);
#pragma unroll
                for (int g = 0; g < 8; ++g) {
                    if (g + 1 < 8) {
#pragma unroll
                        for (int d = 0; d < 2; ++d) va[(g + 1) & 1][d] = *(const LAS bf16x8*)(vp + (((g + 1) & 1) * 2 + d) * 4096 + coff[((g + 1) >> 1) & 3]);
                    }
#pragma unroll
                    for (int d = 0; d < 2; ++d) o[(g & 1) * 2 + d] = __builtin_amdgcn_mfma_f32_32x32x16_bf16(va[g & 1][d], pf[g >> 1], o[(g & 1) * 2 + d], 0, 0, 0);
                    AT_EXP(2 * g); AT_EXP(2 * g + 1);
                    __builtin_amdgcn_sched_barrier(0);
                }
            } else {
#pragma unroll
                for (int r = 0; r < 16; ++r) AT_EXP(r);
            }
            AT_PACK();
            if (resc) { l *= ra;
#pragma unroll
                for (int d = 0; d < 4; ++d) o[d] *= ra; }
            l += (lsa[0] + lsa[1]) + (lsb[0] + lsb[1]);
            havepf = true;
        }
    }
    if (havepf) {
        const LAS unsigned char* vp = lds + ((i + 3) & 3) * AT_STG + 16384 + r32 * 128;
#pragma unroll
        for (int ks = 0; ks < 4; ++ks)
#pragma unroll
            for (int d = 0; d < 4; ++d) { const bf16x8 a = *(const LAS bf16x8*)(vp + d * 4096 + coff[ks]); o[d] = __builtin_amdgcn_mfma_f32_32x32x16_bf16(a, pf[ks], o[d], 0, 0, 0); }
    }
#undef AT_EXP
#undef AT_PACK
#undef AT_ISSUE
    asm volatile("s_waitcnt vmcnt(0) lgkmcnt(0)" ::: "memory");
    __builtin_amdgcn_s_barrier();
    asm volatile("" ::: "memory");
    l = xor32_sum(l);
    const float il = __builtin_amdgcn_rcpf(l);
    LAS float* xch = (LAS float*)(lds + wq * 16384) + lane;
    if (mp == 1) { const float lil = lam * il;
#pragma unroll
        for (int d = 0; d < 4; ++d)
#pragma unroll
            for (int r = 0; r < 16; ++r) xch[(d * 16 + r) * 64] = o[d][r] * lil; }
    __syncthreads();
    if (mp == 0) {
        float ss = 0.f;
#pragma unroll
        for (int d = 0; d < 4; ++d)
#pragma unroll
            for (int r = 0; r < 16; ++r) { const float a0 = o[d][r] * il - xch[(d * 16 + r) * 64]; o[d][r] = a0; ss += a0 * a0; }
        ss = xor32_sum(ss);
        const float rs = rsqrtf(ss * (1.f / 128.f) + 1e-5f) * one_m_li;
        const float* sw_ = P.in[11] + (size_t)li * 128;
        bf16_t* za = (bf16_t*)(P.ws + WS_ZA) + tok * 1024 + h * 128;
#pragma unroll
        for (int d = 0; d < 4; ++d)
#pragma unroll
            for (int q = 0; q < 4; ++q) { const int dd = d * 32 + 8 * q + 4 * hi; const f32x4 w4 = *(const f32x4*)(sw_ + dd); const u32x2 z = *(const u32x2*)(za + dd);
                const float y0 = o[d][4 * q] * rs * w4[0] * silu(bf_lo(z[0])), y1 = o[d][4 * q + 1] * rs * w4[1] * silu(bf_hi(z[0]));
                const float y2 = o[d][4 * q + 2] * rs * w4[2] * silu(bf_lo(z[1])), y3 = o[d][4 * q + 3] * rs * w4[3] * silu(bf_hi(z[1]));
                u32x2 w; w.x = cvt_pk_bf16(y0, y1); w.y = cvt_pk_bf16(y2, y3); *(u32x2*)(za + dd) = w; }
    }
}

constexpr int CTL_BAR = 1024;
#define XB_TMO      128
#define XB_XCNT(j)  (256  + 64 * (j))
#define XB_XSUB(j)  (1280 + 64 * (j))
#define XB_XGEN(j)  (2304 + 64 * (j))
#define XB_TOP      3328
#define XB_TOPGEN   3392
#define XCD_BAR_WORDS 3456
#define XB_SPIN_CAP (1u << 18)
__device__ __forceinline__ unsigned xb_ld(unsigned* p)              { return __hip_atomic_load(p, __ATOMIC_RELAXED, __HIP_MEMORY_SCOPE_AGENT); }
__device__ __forceinline__ unsigned xb_add(unsigned* p, unsigned v) { return __hip_atomic_fetch_add(p, v, __ATOMIC_RELAXED, __HIP_MEMORY_SCOPE_AGENT); }
__device__ __forceinline__ unsigned xb_xcc_id() { return (unsigned)__builtin_amdgcn_s_getreg((3 << 11) | 20) & 0xFu; }
#define XB_SPIN(cond, bar) do { unsigned _sp = 0; while (cond) { __builtin_amdgcn_s_sleep(1); \
    if ((++_sp & 255u) == 0u) { if (xb_ld(&(bar)[XB_TMO])) break; if (_sp > XB_SPIN_CAP) { atomicAdd(&(bar)[XB_TMO], 1u); break; } } } } while (0)
struct XcdBarrier { unsigned* bar; unsigned x; volatile LAS unsigned* st; };
__device__ __forceinline__ XcdBarrier xcd_barrier_post(unsigned* bar, volatile LAS unsigned* st) {
    XcdBarrier b; b.bar = bar; b.x = xb_xcc_id(); b.st = st;
    if (threadIdx.x == 0) (void)xb_add(&bar[XB_XCNT(b.x)], 1u);
    return b;
}
__device__ __forceinline__ void xcd_barrier_complete(unsigned* bar, unsigned x, unsigned& nloc, unsigned& nx) {
    const unsigned G = gridDim.x * gridDim.y * gridDim.z;
    unsigned sum, cnt, mine, sp = 0u;
    for (;;) {
        sum = 0u; cnt = 0u; mine = 0u;
#pragma unroll
        for (unsigned j = 0; j < 16; ++j) { const unsigned c = xb_ld(&bar[XB_XCNT(j)]); sum += c; cnt += (c > 0u) ? 1u : 0u; mine = (j == x) ? c : mine; }
        if (sum == G) break;
        __builtin_amdgcn_s_sleep(1);
        if ((++sp & 255u) == 0u) { if (xb_ld(&bar[XB_TMO])) break; if (sp > XB_SPIN_CAP) { atomicAdd(&bar[XB_TMO], 1u); break; } }
    }
    nloc = mine > 0u ? mine : 1u; nx = cnt > 0u ? cnt : 1u;
}
__device__ __forceinline__ void xcd_barrier(const XcdBarrier& b) {
    asm volatile("s_waitcnt vmcnt(0)" ::: "memory");
    __syncthreads();
    if (threadIdx.x == 0) {
        unsigned* bar = b.bar;
        __builtin_amdgcn_s_waitcnt(0);
        unsigned nloc = b.st[0], nx = b.st[1];
        if (nloc == 0u) { xcd_barrier_complete(bar, b.x, nloc, nx); b.st[0] = nloc; b.st[1] = nx; }
        const unsigned old = xb_add(&bar[XB_XSUB(b.x)], 1u);
        const unsigned gen = old / nloc;
        if (old + 1u == (gen + 1u) * nloc) {
            __builtin_amdgcn_fence(__ATOMIC_RELEASE, "agent");
            asm volatile("s_waitcnt vmcnt(0)" ::: "memory");
            const unsigned og = xb_add(&bar[XB_TOP], 1u);
            const unsigned tg = og / nx;
            if (og + 1u == (tg + 1u) * nx) xb_add(&bar[XB_TOPGEN], 1u);
            else XB_SPIN(xb_ld(&bar[XB_TOPGEN]) == tg, bar);
            __builtin_amdgcn_fence(__ATOMIC_ACQUIRE, "agent");
            xb_add(&bar[XB_XGEN(b.x)], 1u);
            asm volatile("s_waitcnt vmcnt(0)" ::: "memory");
        } else {
            XB_SPIN(xb_ld(&bar[XB_XGEN(b.x)]) == gen, bar);
            __builtin_amdgcn_fence(__ATOMIC_ACQUIRE, "agent");
            asm volatile("s_waitcnt vmcnt(0)" ::: "memory");
        }
    }
    __syncthreads();
}
#ifndef PHMASK
#define PHMASK 0xFFFF
#endif
#define PH(k) ((PHMASK >> (k)) & 1)
#ifndef DBG_NO_ATT
#define DBG_NO_ATT 0
#endif
#ifndef DBG_NO_SSM
#define DBG_NO_SSM 0
#endif
__global__ void __launch_bounds__(512, 2) trunk_fwd(Params P) {
    extern __shared__ __attribute__((aligned(16))) unsigned char lds_raw[];
    LAS unsigned char* lds = (LAS unsigned char*)lds_raw;
    cg::grid_group grid = cg::this_grid();
    int tid = threadIdx.x, lane = tid & 63, wid = __builtin_amdgcn_readfirstlane(tid >> 6);
    int G = gridDim.x, bx = blockIdx.x;
    int vcu = (G % 8 == 0) ? (bx % 8) * (G / 8) + bx / 8 : bx;
    int gw = vcu * 8 + wid; const int NGW = G * 8;
    Params Q = P;
    unsigned char* ws = Q.ws;
    bf16_t* XB = (bf16_t*)(ws + WS_XB);
#define LAUNDER() do { tid = threadIdx.x; asm volatile("" : "+v"(tid)); lane = tid & 63; wid = __builtin_amdgcn_readfirstlane(tid >> 6); bx = blockIdx.x; asm volatile("" : "+s"(bx)); \
        vcu = (G % 8 == 0) ? (bx % 8) * (G / 8) + bx / 8 : bx; gw = vcu * 8 + wid; ws = P.ws; asm volatile("" : "+s"(ws)); Q.ws = ws; XB = (bf16_t*)(ws + WS_XB); } while (0)

#define GSYNC() xcd_barrier(xbar)
    if (bx == 0) for (int z = tid; z < CTL_BAR + XCD_BAR_WORDS; z += 512) ((unsigned*)ws)[z] = 0u;
    volatile LAS unsigned* xst = (volatile LAS unsigned*)(lds + LDS_BYTES - 64);
    if (tid < 2) xst[tid] = 0u;
    __syncthreads();
    for (int it = bx; it < NG * 4; it += G) ssm_tables(Q, 0, lds, it);
    __syncthreads();
    if (PH(0)) convert_weights(Q, 0, lds, gw, NGW, lane, wid);
    { const float* x = P.in[0]; const size_t n8 = (size_t)T * DM / 8, gt = (size_t)gw * 64 + lane, NT_ = (size_t)NGW * 64;
#pragma unroll 4
      for (size_t i = gt; i < n8; i += NT_) { const f32x4 a = *(const f32x4*)(x + i * 8), b = *(const f32x4*)(x + i * 8 + 4);
          u32x4 w; w.x = cvtpk(a[0], a[1]); w.y = cvtpk(a[2], a[3]); w.z = cvtpk(b[0], b[1]); w.w = cvtpk(b[2], b[3]); *(u32x4*)(XB + i * 8) = w;
          *(u32x2*)(ws + WS_XB8 + i * 8) = (u32x2){cvt4_fp8(a[0], a[1], a[2], a[3]), cvt4_fp8(b[0], b[1], b[2], b[3])}; } }
    grid.sync();
    const XcdBarrier xbar = xcd_barrier_post((unsigned*)P.ws + CTL_BAR, xst);

#pragma unroll 1
    for (int li = 0; li < DEPTH; ++li) {
        const float lambda_init = (li == 0) ? 0.2f : 0.35550906759096783f;
        LAUNDER();
        {
            pg8::Gemm g{(const bf16_t*)(ws + WS_XB8), (const bf16_t*)(ws + WS_WIN), T, NCOLS, DM / 2, 2}; pg8::StaticOrder S; S.init(T, NCOLS, G, bx, FP8_TILES);
            Epi<EPI_INPROJ> E{}; E.ws = ws; E.sc_all = 1.0f / 64.0f;
            pg8::gemm_phase<Epi<EPI_INPROJ>, pg8::StaticOrder, true>(lds, g, S, E); }
        if (PH(1)) {   pg8::Gemm g{XB, (const bf16_t*)(ws + WS_WIN), T, NCOLS, DM}; pg8::StaticOrder S; S.init(T, NCOLS, G, bx, BF16_TILES);
            Epi<EPI_INPROJ> E{}; E.ws = ws; E.sc_all = 1.0f;
            pg8::gemm_phase(lds, g, S, E); }
        GSYNC();
        LAUNDER();
        if (PH(2)) {   pg8::Gemm g{(const bf16_t*)(ws + WS_WIN) + (size_t)2048 * DM, XB, AW, T, DM}; pg8::StaticOrder S; S.init(AW, T, G, bx);
            Epi<EPI_PLAIN> E{}; E.O = (bf16_t*)(ws + WS_VT); E.ldc = T;
            pg8::gemm_phase(lds, g, S, E); }
#if !DBG_NO_SSM
        LAUNDER();
        if (PH(4)) for (int it = gw; it < NG * 16 * 4; it += NGW) ssm_local(Q, it, lane);
#endif
        GSYNC();
#if !DBG_NO_SSM
        LAUNDER();
        if (PH(5)) { const int nb = (G >= 128) ? 128 : G;
            if (bx < nb) for (int wv_ = bx + nb * wid; wv_ < 128; wv_ += nb * 8) ssm_scan(Q, wv_ * 64 + lane); }
        for (int it = gw; it < NCH * 16; it += NGW) kmax_task(Q, it, lane);
        GSYNC();
#endif
        LAUNDER();
#if !DBG_NO_SSM
        if (PH(6)) for (int u = vcu; u < NG * 16; u += G) ssm_y_unit(Q, li, lds, u);
#endif
#if !DBG_NO_ATT
        if (PH(7)) {   float lam;
            { const float a = P.in[7][li * 64 + lane] * P.in[8][li * 64 + lane], b2 = P.in[9][li * 64 + lane] * P.in[10][li * 64 + lane];
              lam = expf(wave_sum(a, lane)) - expf(wave_sum(b2, lane)) + lambda_init; }
            LAS unsigned* qslot = (LAS unsigned*)(lds + AT_CTL) + 1;
            for (;;) {
                __syncthreads();
                if (tid == 0) *qslot = atomicAdd((unsigned*)ws + CTL_QCTR, 1u);
                __syncthreads();
                const unsigned u = *qslot;
                if (u >= 2048u) break;
                const int bhr = (int)(u >> 7), qb = 127 - (int)(u & 127);
                attn_unit(Q, li, lds, bhr & 1, 7 - (bhr >> 1), qb, lam, 1.0f - lambda_init);
            }
        }
#endif
        GSYNC();
        LAUNDER();
#if !DBG_NO_SSM
        if (PH(8)) {   pg8::Gemm g{(const bf16_t*)(ws + WS_YG8), (const bf16_t*)(ws + WS_WGLU), T, AW, AW / 2}; pg8::StaticOrder S; S.init(T, AW, G, bx);
            Epi<EPI_GLU> E{}; E.O = (bf16_t*)(ws + WS_ZS); E.ldc = AW; E.X1 = (const bf16_t*)(ws + WS_YG); E.sc_all = 1.0f / 64.0f;
            pg8::gemm_phase<Epi<EPI_GLU>, pg8::StaticOrder, true>(lds, g, S, E); }
        GSYNC();
#endif
        LAUNDER();
        if (PH(9)) {   pg8::Gemm g{(const bf16_t*)(ws + WS_ZA), (const bf16_t*)(ws + WS_WAO), T, DM, AW}; pg8::StaticOrder S; S.init(T, DM, G, bx);
            Epi<EPI_MRG_A> E{}; E.O = (bf16_t*)(ws + WS_GA); E.ldc = DM;
            pg8::gemm_phase(lds, g, S, E); }
        if (PH(10)) {   pg8::Gemm g{(const bf16_t*)(ws + WS_ZS), (const bf16_t*)(ws + WS_WSO), T, DM, AW}; pg8::StaticOrder S; S.init(T, DM, G, bx);
            Epi<EPI_MRG_B> E{}; E.O = (bf16_t*)(ws + WS_GA); E.ldc = DM; E.X1 = (const bf16_t*)(ws + WS_GS);
            pg8::gemm_phase(lds, g, S, E); }
        GSYNC();
        LAUNDER();
        if (PH(12)) {   pg8::Gemm g{(const bf16_t*)(ws + WS_PB), (const bf16_t*)(ws + WS_WPLE), T, DM, PLE}; pg8::StaticOrder S; S.init(T, DM, G, bx);
            Epi<EPI_MRG_A> E{}; E.O = (bf16_t*)(ws + WS_GP); E.ldc = DM;
            pg8::gemm_phase(lds, g, S, E); }
        const bool ln_fused = (G == 256);
        if (ln_fused) {   pg8::Gemm g{(const bf16_t*)(ws + WS_GA), (const bf16_t*)(ws + WS_WOUT), T, DM, DM}; pg8::StaticOrder S; S.init(T, DM, G, bx); S.wgm = 4;
            EpiOutLn E{}; E.res = (li == 0) ? P.in[0] : P.out; E.out = P.out; E.ple = (const bf16_t*)(ws + WS_GP); E.g = P.in[21] + (size_t)li * DM; E.b = P.in[22] + (size_t)li * DM;
            E.xb = (li + 1 < DEPTH) ? XB : nullptr; E.xb8 = ws + WS_XB8; E.stats = (unsigned long long*)(ws + WS_LNSTAT); E.cnt = (unsigned*)ws + CTL_LNCNT + li * 128;
            pg8::gemm_phase(lds, g, S, E); }
        else if (PH(11)) {   pg8::Gemm g{(const bf16_t*)(ws + WS_GA), (const bf16_t*)(ws + WS_WOUT), T, DM, DM}; pg8::StaticOrder S; S.init(T, DM, G, bx);
            Epi<EPI_OUT_A> E{}; E.res = (li == 0) ? P.in[0] : P.out; E.out = P.out; E.ldc = DM; E.X1 = (const bf16_t*)(ws + WS_GP);
            pg8::gemm_phase(lds, g, S, E); }
        if (li + 1 < DEPTH) { __syncthreads(); convert_weights(Q, li + 1, lds, gw, NGW, lane, wid, 1); }
        if (!ln_fused || li + 1 < DEPTH) GSYNC();
        LAUNDER();
        if (!ln_fused && PH(13)) ln_rows(P.out, P.in[21] + (size_t)li * DM, P.in[22] + (size_t)li * DM, (li + 1 < DEPTH) ? XB : nullptr, ws + WS_XB8, gw, NGW, lane);
        if (li + 1 < DEPTH) { __syncthreads(); if (bx == 0 && tid < 80) ((unsigned*)ws)[tid] = 0u; for (int it = bx; it < NG * 4; it += G) ssm_tables(Q, li + 1, lds, it);
            __syncthreads(); if (PH(0)) convert_weights(Q, li + 1, lds, gw, NGW, lane, wid, 2); GSYNC(); }
    }
}

extern "C" void kernel_launch(void* const* d_in, const int* in_sizes, int n_in, void* d_out, int out_size, void* d_ws, size_t ws_size, hipStream_t stream) {
    static int grid = 0;
    if (grid == 0) {
        if (n_in != 23 || ws_size < WS_END) { fprintf(stderr, "kernel_launch: unexpected n_in %d / ws %zu\n", n_in, ws_size); grid = -1; return; }
        int dev = 0, cus = 0, per_cu = 0;
        hipGetDevice(&dev); hipDeviceGetAttribute(&cus, hipDeviceAttributeMultiprocessorCount, dev);
        if (hipFuncSetAttribute((const void*)trunk_fwd, hipFuncAttributeMaxDynamicSharedMemorySize, LDS_BYTES) != hipSuccess) { fprintf(stderr, "hipFuncSetAttribute failed\n"); grid = -1; return; }
        hipOccupancyMaxActiveBlocksPerMultiprocessor(&per_cu, (const void*)trunk_fwd, 512, LDS_BYTES);
        if (per_cu < 1) { fprintf(stderr, "occupancy query says %d\n", per_cu); per_cu = 1; }
        (void)hipGetLastError();
        grid = cus;
    }
    if (grid < 0) return;
    Params p{};
    for (int i = 0; i < 23; ++i) p.in[i] = (const float*)d_in[i];
    p.out = (float*)d_out; p.ws = (unsigned char*)d_ws;
    void* args[] = {&p};
    hipError_t e = hipLaunchCooperativeKernel((const void*)trunk_fwd, dim3(grid), dim3(512), args, LDS_BYTES, stream);
    if (e != hipSuccess) fprintf(stderr, "cooperative launch failed: %s (grid %d)\n", hipGetErrorString(e), grid);
}
```
